# Optimizing an MI355X kernel written in HIP

```python
import math
import jax, jax.numpy as jnp
from jax import lax
import numpy as np

D_MODEL = 2048
BATCH = 8
SEQ = 2048
DEPTH = 2

HEAD_DIM = 128
ATTN_WIDTH = D_MODEL // 2
ATTN_HEADS = ATTN_WIDTH // HEAD_DIM
POOL_WIDTH = D_MODEL // 4
POOL_WINDOWS = (2, 4, 8, 16)
POOL_GROUPS = len(POOL_WINDOWS)
POOL_GROUP_DIM = POOL_WIDTH // POOL_GROUPS
CONV_WIDTH = D_MODEL // 4
CONV_K = 3
D_MIX = ATTN_WIDTH + POOL_WIDTH + CONV_WIDTH
IN_PROJ_SPLITS = (ATTN_WIDTH, ATTN_WIDTH, ATTN_WIDTH, POOL_WIDTH, CONV_WIDTH, CONV_WIDTH, CONV_WIDTH)
D_IN_PROJ = sum(IN_PROJ_SPLITS)

MOBA_BLOCK = 256
MOBA_TOPK = 3
QUERY_CHUNK = 16
ATTN_SCALE = HEAD_DIM ** -0.5

REL_BUCKETS = 32
REL_MAX_DISTANCE = 128

N_EXPERTS = 32
TOPK_EXPERTS = 4
D_EXPERT = D_MODEL // 2
SWIGLU_LIMIT = 7.0
SWIGLU_ALPHA = 1.702
EXPERT_ROW_BLOCK = 512

N_MOD = 6
RMS_EPS = 1e-6
NEG_INF = -1e30

kernel_name = "hybrid_moba_pool_conv_moe_block"


def _normal(k, shape, scale):
    return jax.random.normal(k, shape, jnp.float32) * scale


def rms_norm(x, g):
    xf = x.astype(jnp.float32)
    y = xf * lax.rsqrt(jnp.mean(xf * xf, axis=-1, keepdims=True) + RMS_EPS)
    return (y * g.astype(jnp.float32)).astype(x.dtype)


def rel_bucket(rel):
    n = jnp.maximum(-rel, 0)
    max_exact = REL_BUCKETS // 2
    nf = jnp.maximum(n, max_exact).astype(jnp.float32)
    large = max_exact + (jnp.log(nf / max_exact) / math.log(REL_MAX_DISTANCE / max_exact)
                         * (REL_BUCKETS - max_exact)).astype(jnp.int32)
    large = jnp.minimum(large, REL_BUCKETS - 1)
    return jnp.where(n < max_exact, n, large)


def moba_attention(q, k, v, rel_bias):
    B, S, _ = q.shape
    H, Dh = ATTN_HEADS, HEAD_DIM
    q = q.reshape(B, S, H, Dh).transpose(0, 2, 1, 3)
    k = k.reshape(B, S, H, Dh).transpose(0, 2, 1, 3)
    v = v.reshape(B, S, H, Dh).transpose(0, 2, 1, 3)
    n_blk = -(-S // MOBA_BLOCK)
    pad = n_blk * MOBA_BLOCK - S
    kb = jnp.pad(k, ((0, 0), (0, 0), (0, pad), (0, 0))).reshape(B, H, n_blk, MOBA_BLOCK, Dh)
    vb = jnp.pad(v, ((0, 0), (0, 0), (0, pad), (0, 0))).reshape(B, H, n_blk, MOBA_BLOCK, Dh)

    k_mean = jnp.mean(kb.astype(jnp.float32), axis=3).astype(q.dtype)
    gate = jnp.einsum('bhsd,bhnd->bhsn', q, k_mean, preferred_element_type=jnp.float32)
    q_blk = jnp.arange(S) // MOBA_BLOCK
    past = jnp.arange(n_blk)[None, :] < q_blk[:, None]
    gate = jnp.where(past, gate, NEG_INF)
    kk = min(MOBA_TOPK, n_blk)
    _, sel = lax.top_k(gate, kk)
    sel_ok = sel < q_blk[:, None]

    n_chunk = S // QUERY_CHUNK

    def chunks(a):
        a = a.reshape(B, H, n_chunk, QUERY_CHUNK, *a.shape[3:])
        return jnp.moveaxis(a, 2, 0)

    starts = jnp.arange(n_chunk, dtype=jnp.int32) * QUERY_CHUNK
    table_h = rel_bias.T.astype(jnp.float32)
    head_ix = jnp.arange(H)[:, None, None, None]
    gather_blocks = jax.vmap(jax.vmap(lambda blocks, ix: blocks[ix]))

    def body(args):
        qc, sc, okc, start = args
        qpos = start + jnp.arange(QUERY_CHUNK)
        own = start // MOBA_BLOCK
        k_own = lax.dynamic_index_in_dim(kb, own, axis=2, keepdims=False)
        v_own = lax.dynamic_index_in_dim(vb, own, axis=2, keepdims=False)
        rel_own = own * MOBA_BLOCK + jnp.arange(MOBA_BLOCK)[None, :] - qpos[:, None]
        l_own = (jnp.einsum('bhqd,bhkd->bhqk', qc, k_own, preferred_element_type=jnp.float32) * ATTN_SCALE
                 + table_h[:, rel_bucket(rel_own)])
        l_own = jnp.where(rel_own <= 0, l_own, NEG_INF)
        k_sel = gather_blocks(kb, sc)
        v_sel = gather_blocks(vb, sc)
        rel_sel = sc[..., None] * MOBA_BLOCK + jnp.arange(MOBA_BLOCK) - qpos[:, None, None]
        l_sel = (jnp.einsum('bhqd,bhqnkd->bhqnk', qc, k_sel, preferred_element_type=jnp.float32) * ATTN_SCALE
                 + table_h[head_ix, rel_bucket(rel_sel)])
        l_sel = jnp.where(okc[..., None], l_sel, NEG_INF)
        n_sel = kk * MOBA_BLOCK
        logits = jnp.concatenate([l_sel.reshape(B, H, QUERY_CHUNK, n_sel), l_own], axis=-1)
        p = jax.nn.softmax(logits, axis=-1).astype(v.dtype)
        p_sel = p[..., :n_sel].reshape(B, H, QUERY_CHUNK, kk, MOBA_BLOCK)
        p_own = p[..., n_sel:]
        return (jnp.einsum('bhqnk,bhqnkd->bhqd', p_sel, v_sel)
                + jnp.einsum('bhqk,bhkd->bhqd', p_own, v_own))

    out = lax.map(body, (chunks(q), chunks(sel), chunks(sel_ok), starts))
    out = jnp.moveaxis(out, 0, 2).reshape(B, H, S, Dh)
    return out.transpose(0, 2, 1, 3).reshape(B, S, H * Dh)


def pool_mixer(u, w_pool, pool_scale):
    B, S, _ = u.shape
    ug = u.astype(jnp.float32).reshape(B, S, POOL_GROUPS, POOL_GROUP_DIM)
    cs = jnp.concatenate([jnp.zeros((B, 1, POOL_GROUPS, POOL_GROUP_DIM), jnp.float32),
                          jnp.cumsum(ug, axis=1)], axis=1)
    t = jnp.arange(1, S + 1)
    pooled = []
    for gi, w in enumerate(POOL_WINDOWS):
        csg = cs[:, :, gi]
        start = jnp.maximum(t - w, 0)
        win_sum = csg[:, 1:] - jnp.take(csg, start, axis=1)
        count = jnp.minimum(t, w).astype(jnp.float32)
        pooled.append(win_sum / count[None, :, None])
    pooled = jnp.stack(pooled, axis=2)
    d = (pooled - ug).astype(u.dtype)
    y = jnp.einsum('bsgc,gcd->bsgd', d, w_pool).reshape(B, S, POOL_WIDTH)
    return y * pool_scale


def conv_mixer(gate_b, gate_c, h_in, conv_w):
    u = gate_c * h_in
    conv = lax.conv_general_dilated(u, conv_w[:, None, :], window_strides=(1,),
                                    padding=[(CONV_K - 1, 0)],
                                    dimension_numbers=('NWC', 'WIO', 'NWC'),
                                    feature_group_count=CONV_WIDTH)
    return gate_b * conv


def clamped_swiglu(g, u):
    g = jnp.minimum(g, SWIGLU_LIMIT)
    u = jnp.clip(u, -SWIGLU_LIMIT, SWIGLU_LIMIT)
    return g * jax.nn.sigmoid(SWIGLU_ALPHA * g) * (u + 1)


def moe_ffn(h, router_w, router_b, w_gate, b_gate, w_up, b_up, w_down, b_down):
    B, S, D = h.shape
    T = B * S
    xt = h.reshape(T, D)
    logits = (xt @ router_w + router_b).astype(jnp.float32)
    top_val, top_idx = lax.top_k(logits, TOPK_EXPERTS)
    gates = jax.nn.softmax(top_val, axis=-1)
    M = T * TOPK_EXPERTS
    e_flat = top_idx.reshape(M)
    order = jnp.argsort(e_flat)
    e_sorted = e_flat[order]
    tok_sorted = order // TOPK_EXPERTS
    counts = jnp.bincount(e_flat, length=N_EXPERTS)
    padded = ((counts + EXPERT_ROW_BLOCK - 1) // EXPERT_ROW_BLOCK) * EXPERT_ROW_BLOCK
    pad_end = jnp.cumsum(padded)
    pad_start = pad_end - padded
    grp_start = jnp.cumsum(counts) - counts
    dest = pad_start[e_sorted] + (jnp.arange(M) - grp_start[e_sorted])
    n_rb = -(-M // EXPERT_ROW_BLOCK) + N_EXPERTS
    P = n_rb * EXPERT_ROW_BLOCK
    xp = jnp.zeros((P, D), xt.dtype).at[dest].set(xt[tok_sorted])
    rb_expert = jnp.minimum(jnp.searchsorted(pad_end, jnp.arange(n_rb) * EXPERT_ROW_BLOCK, side='right'),
                            N_EXPERTS - 1)

    def expert_rows(args):
        xb, e = args
        g = xb @ w_gate[e] + b_gate[e]
        u = xb @ w_up[e] + b_up[e]
        return clamped_swiglu(g, u) @ w_down[e] + b_down[e]

    yp = lax.map(expert_rows, (xp.reshape(n_rb, EXPERT_ROW_BLOCK, D), rb_expert)).reshape(P, D)
    y_sorted = yp[dest] * gates.reshape(M)[order][:, None].astype(yp.dtype)
    y = jax.ops.segment_sum(y_sorted, tok_sorted, num_segments=T)
    return y.reshape(B, S, D)


def setup_inputs(seed: int = 0) -> dict:
    key = jax.random.key(seed)
    ks = jax.random.split(key, 24)
    L = DEPTH
    gain = lambda k: 1.0 + _normal(k, (L, D_MODEL), 0.1)
    return {
        "x": _normal(ks[0], (BATCH, SEQ, D_MODEL), 1.0),
        "c": _normal(ks[1], (BATCH, D_MODEL), 1.0),
        "w_ada": _normal(ks[2], (L, D_MODEL, N_MOD * D_MODEL), 0.5 * D_MODEL ** -0.5),
        "b_ada": _normal(ks[3], (L, N_MOD * D_MODEL), 0.01),
        "g_pre_mix": gain(ks[4]),
        "g_post_mix": gain(ks[5]),
        "g_pre_ffn": gain(ks[6]),
        "g_post_ffn": gain(ks[7]),
        "w_in": _normal(ks[8], (L, D_MODEL, D_IN_PROJ), D_MODEL ** -0.5),
        "w_out": _normal(ks[9], (L, D_MIX, D_MODEL), D_MIX ** -0.5),
        "pool_w": _normal(ks[10], (L, POOL_GROUPS, POOL_GROUP_DIM, POOL_GROUP_DIM), POOL_GROUP_DIM ** -0.5),
        "pool_scale": 1.0 + _normal(ks[11], (L, POOL_WIDTH), 0.1),
        "conv_w": _normal(ks[12], (L, CONV_K, CONV_WIDTH), CONV_K ** -0.5),
        "rel_bias": _normal(ks[13], (REL_BUCKETS, ATTN_HEADS), 0.5),
        "router_w": _normal(ks[14], (L, D_MODEL, N_EXPERTS), D_MODEL ** -0.5),
        "router_b": _normal(ks[15], (L, N_EXPERTS), 0.01),
        "w_gate": _normal(ks[16], (L, N_EXPERTS, D_MODEL, D_EXPERT), D_MODEL ** -0.5),
        "b_gate": _normal(ks[17], (L, N_EXPERTS, D_EXPERT), 0.01),
        "w_up": _normal(ks[18], (L, N_EXPERTS, D_MODEL, D_EXPERT), D_MODEL ** -0.5),
        "b_up": _normal(ks[19], (L, N_EXPERTS, D_EXPERT), 0.01),
        "w_down": _normal(ks[20], (L, N_EXPERTS, D_EXPERT, D_MODEL), D_EXPERT ** -0.5),
        "b_down": _normal(ks[21], (L, N_EXPERTS, D_MODEL), 0.01),
    }


def reference(x, c, w_ada, b_ada, g_pre_mix, g_post_mix, g_pre_ffn, g_post_ffn, w_in, w_out,
              pool_w, pool_scale, conv_w, rel_bias, router_w, router_b,
              w_gate, b_gate, w_up, b_up, w_down, b_down):
    c_act = jax.nn.silu(c)
    split_points = np.cumsum(IN_PROJ_SPLITS)[:-1].tolist()
    for l in range(DEPTH):
        mod = c_act @ w_ada[l] + b_ada[l]
        sh_m, sc_m, gt_m, sh_f, sc_f, gt_f = jnp.split(mod[:, None, :], N_MOD, axis=-1)

        h = rms_norm(x, g_pre_mix[l]) * (1 + sc_m) + sh_m
        proj = h @ w_in[l]
        q, k, v, u_pool, gate_b, gate_c, h_conv = jnp.split(proj, split_points, axis=-1)
        y_att = moba_attention(q, k, v, rel_bias)
        y_pool = pool_mixer(u_pool, pool_w[l], pool_scale[l])
        y_conv = conv_mixer(gate_b, gate_c, h_conv, conv_w[l])
        mix = jnp.concatenate([y_att, y_pool, y_conv], axis=-1) @ w_out[l]
        x = x + gt_m * rms_norm(mix, g_post_mix[l])

        h = rms_norm(x, g_pre_ffn[l]) * (1 + sc_f) + sh_f
        ffn = moe_ffn(h, router_w[l], router_b[l], w_gate[l], b_gate[l], w_up[l], b_up[l],
                      w_down[l], b_down[l])
        x = x + gt_f * rms_norm(ffn, g_post_ffn[l])
    return x
```

```cpp
#include <hip/hip_runtime.h>
#include <cstdio>
#include <cstdint>

constexpr int D = 2048, NB = 8, S = 2048, T = NB * S, NL = 2;
constexpr int DIN = 5120, NH = 8;
constexpr int NE = 32, TK = 4, DE = 1024;
constexpr int NMOD = 6 * D;
constexpr float EPS = 1e-6f;
constexpr float ATT_SCALE = 0.08838834764831845f;
constexpr int PROWS = T * TK + NE * 256;

#define GAS __attribute__((address_space(1)))
#define LAS __attribute__((address_space(3)))
typedef unsigned short bf16;
typedef unsigned v4u __attribute__((ext_vector_type(4)));
typedef unsigned v2u __attribute__((ext_vector_type(2)));
typedef float f32x4 __attribute__((ext_vector_type(4)));
typedef short bf16x8 __attribute__((ext_vector_type(8)));
#define LDS_WAIT() asm volatile("s_waitcnt lgkmcnt(0)" ::: "memory")
#define VM_WAIT() asm volatile("s_waitcnt vmcnt(0)" ::: "memory")
__device__ __forceinline__ unsigned f2bf(float f) { unsigned u = __builtin_bit_cast(unsigned, f); return (u + 0x7fffu + ((u >> 16) & 1u)) >> 16; }
__device__ __forceinline__ unsigned pk2(float lo, float hi) { return f2bf(lo) | (f2bf(hi) << 16); }
__device__ __forceinline__ float bf2f(unsigned b) { return __builtin_bit_cast(float, b << 16); }
__device__ __forceinline__ float clamp448(float x) { return __builtin_fminf(__builtin_fmaxf(x, -448.f), 448.f); }
__device__ __forceinline__ unsigned pk4_fp8(float a, float b, float c, float d) {
    unsigned w = __builtin_amdgcn_cvt_pk_fp8_f32(clamp448(a), clamp448(b), 0, false);
    return __builtin_amdgcn_cvt_pk_fp8_f32(clamp448(c), clamp448(d), w, true);
}
typedef float f32x2_t __attribute__((ext_vector_type(2)));
__device__ __forceinline__ f32x4 unpk4_fp8(unsigned w) { const f32x2_t lo = __builtin_amdgcn_cvt_pk_f32_fp8(w, false), hi = __builtin_amdgcn_cvt_pk_f32_fp8(w, true); return (f32x4){lo.x, lo.y, hi.x, hi.y}; }
__device__ __forceinline__ float bflo(unsigned w) { return __builtin_bit_cast(float, w << 16); }
__device__ __forceinline__ float bfhi(unsigned w) { return __builtin_bit_cast(float, w & 0xffff0000u); }

constexpr size_t MiB = 1u << 20;
constexpr size_t WS_CTL = 0, CTL_ZERO_BYTES = 2 * MiB;
constexpr size_t WS_KMEAN = 1 * MiB;
constexpr size_t WS_MOD = 2 * MiB;
constexpr size_t WS_MODP = 3 * MiB;
constexpr size_t WS_ROUT = 16 * MiB;
constexpr size_t WS_ROWTOK = 17 * MiB;
constexpr size_t WS_WR = 19 * MiB;
constexpr size_t WS_WIN = 20 * MiB;
constexpr size_t WS_WOUT = 60 * MiB;
constexpr size_t WS_WGU = 76 * MiB;
constexpr size_t WS_WDN = 588 * MiB;
constexpr size_t WS_HB8 = 716 * MiB;
constexpr float WSCALE = 64.f;
constexpr size_t WS_HB = 844 * MiB;
constexpr size_t WS_ACT = 908 * MiB;
constexpr size_t WS_YS = 1052 * MiB;
constexpr size_t WS_Q = 1340 * MiB, WS_K = 1372 * MiB, WS_V = 1404 * MiB;
constexpr size_t WS_PCG = 1436 * MiB;
constexpr size_t WS_MIXCAT = 1500 * MiB;
constexpr size_t WS_MIX = 1564 * MiB;
constexpr size_t WS_XB = 1628 * MiB;
constexpr size_t WS_END = 1692 * MiB;
constexpr size_t WS_GUTMP = WS_YS;
static_assert(WS_GUTMP + (size_t)PROWS * 2048 * 4 <= WS_END, "gutmp overlay");
static_assert(WS_V - WS_K == WS_K - WS_Q, "Q/K/V equally spaced");
constexpr int CW_COUNTS = 64;
constexpr int CW_BAR = 4096;
#define XCD_BAR_WORDS 3456
constexpr int MAX_LAUNCH = 24;
static_assert((CW_BAR + MAX_LAUNCH * XCD_BAR_WORDS) * 4 <= (int)(1 * MiB), "ctl words");

constexpr int RING_BYTES = 131072;
constexpr int LDSX_OFF = RING_BYTES;
constexpr int LDS_BYTES = 147456;
constexpr int LX_MISC = LDSX_OFF;
constexpr int LX_TSTART = LDSX_OFF + 64;
constexpr int LX_CNT = LX_TSTART + 160;
constexpr int LX_TILEE = LX_CNT + 128;
constexpr int LX_IDX = LX_TILEE + 1280;
constexpr int LX_BIAS = LX_IDX + 10 * 256 * 4;
static_assert(LX_BIAS + 8 * 256 <= LDS_BYTES, "lds map");
constexpr int NWAVES = 8;

namespace pg8 {
#define PG8_LAS __attribute__((address_space(3)))
typedef unsigned short bf16_t;
typedef unsigned u32x4 __attribute__((ext_vector_type(4)));
constexpr int BM = 256, BK = 64, HALF = 128, HTB = HALF * BK * 2, STAGE_BYTES = 8 * HTB, NXCD = 8, WGM = 4;
__host__ __device__ __forceinline__ int lds_byte(int r, int c) { const int st = (r >> 4) * 2 + (c >> 5), rr = r & 15, cc = c & 31, ob = rr * 64 + cc * 2; return st * 1024 + (ob ^ (((ob >> 9) & 1) << 5)); }
__host__ __device__ __forceinline__ void stage_rc(int b, int& R, int& C) { const int st = b / 1024, sb = b % 1024, swz = sb ^ (((sb >> 9) & 1) << 5); R = (st >> 1) * 16 + swz / 64; C = (st & 1) * 32 + (swz % 64) / 2; }
#define PG8_PQ(fq) ((((fq) & 1) << 1) | ((fq) >> 1))
__host__ __device__ __forceinline__ int perm32(int rho) { const int n = rho >> 4, i = rho & 15; return 8 * PG8_PQ(i >> 2) + 4 * n + (i & 3); }
struct Unit { int pm, pn, e; };
typedef int v4i_t __attribute__((ext_vector_type(4)));
typedef int v8i_t __attribute__((ext_vector_type(8)));
__device__ __forceinline__ unsigned cvt_pk_bf16(float lo, float hi) { unsigned r; asm volatile("v_cvt_pk_bf16_f32 %0, %1, %2" : "=v"(r) : "v"(lo), "v"(hi)); return r; }

struct DenseOrder {
    static constexpr bool GATHER = false;
    int nM, nN, nwg, G, c, K; const char* A; const char* Bt;
    __device__ void init(const bf16_t* A_, const bf16_t* Bt_, int M, int N, int K_, int G_, int c_) { A = (const char*)A_; Bt = (const char*)Bt_; nM = M / BM; nN = N / BM; nwg = nM * nN; G = G_; c = c_; K = K_; }
    __device__ bool next(int i, Unit& u) const {
        const long L = (long)i * G + c; if (L >= nwg) return false;
        int wgid = (int)L; { const int q = nwg / NXCD, r = nwg % NXCD, xcd = wgid % NXCD, off = wgid / NXCD; wgid = (xcd < r ? xcd * (q + 1) : r * (q + 1) + (xcd - r) * q) + off; }
        const int nig = WGM * nN, gid = wgid / nig, fm = gid * WGM, gsz = (nM - fm) < WGM ? (nM - fm) : WGM;
        u.pm = fm + ((wgid % nig) % gsz); u.pn = (wgid % nig) / gsz; u.e = 0; return true;
    }
    __device__ __forceinline__ const char* a_base(const Unit& u) const { return A + (size_t)u.pm * BM * K * 2; }
    __device__ __forceinline__ const char* b_base(const Unit& u) const { return Bt + (size_t)u.pn * BM * K * 2; }
    __device__ __forceinline__ unsigned a_off(int, int) const { return 0u; }
};
struct GroupedOrder {
    int ntiles, G, c, K; const char* A; const char* Bt; const PG8_LAS int* tile_e; const PG8_LAS int* idx;
    __device__ bool next(int i, Unit& u) const {
        const int x = c & 7, j = c >> 3, per = G >> 6, span = (ntiles + 7) >> 3, lo = x * span, off = i * per + (j >> 3), mt = lo + off;
        if (off >= span || mt >= ntiles) return false;
        u.pm = mt; u.pn = j & 7; u.e = tile_e[mt]; return true;
    }
    __device__ __forceinline__ const char* b_base(const Unit& u) const { return Bt + ((size_t)u.e * 2048 + (size_t)u.pn * BM) * K * 2; }
};
struct GroupedGather : GroupedOrder {
    static constexpr bool GATHER = true;
    __device__ __forceinline__ const char* a_base(const Unit&) const { return A; }
    __device__ __forceinline__ unsigned a_off(int ui, int r) const { return (unsigned)idx[ui * 256 + r] * (unsigned)(K * 2); }
};
struct GroupedDense : GroupedOrder {
    static constexpr bool GATHER = false;
    __device__ __forceinline__ const char* a_base(const Unit& u) const { return A + (size_t)u.pm * BM * K * 2; }
    __device__ __forceinline__ unsigned a_off(int, int) const { return 0u; }
};

template <class Epi, class Sched, bool ALIGN_EPI, bool FP8 = false>
__device__ __forceinline__ void gemm_phase(PG8_LAS unsigned char* lds, int K, const Sched& S, const Epi& E) {
    constexpr bool GATHER = Sched::GATHER, RELAX = true;
    int tid_l = threadIdx.x; asm volatile("" : "+v"(tid_l));
    const int tid = tid_l, wid = __builtin_amdgcn_readfirstlane(tid >> 6), lane = tid & 63, wr = wid >> 2, wc = wid & 3, fr = lane & 15, fq = lane >> 4;
    const int nt = K / BK;
    unsigned voffB[2], vAc0[2], vAc1[2], vAn0[2], vAn1[2]; int sR[2], sC[2];
#pragma unroll
    for (int i = 0; i < 2; ++i) { int R, C; stage_rc(tid * 16 + i * 8192, R, C); const int Rb = Epi::PERM ? ((R & ~31) + perm32(R & 31)) : R; sR[i] = R; sC[i] = C;
        voffB[i] = (unsigned)(Rb * K + C) * 2u; vAc0[i] = vAc1[i] = vAn0[i] = vAn1[i] = (unsigned)(R * K + C) * 2u; }
    const size_t kstep = (size_t)(BK * 2);
    const size_t hstep = (size_t)HALF * K * 2;
    const size_t hstepA = GATHER ? 0 : hstep;
    const unsigned ldsw = (unsigned)wid * 1024u;
    const int aoff = lds_byte(wr * 64 + fr, fq * 8), boff = lds_byte(wc * 32 + fr, fq * 8);
#define PG8_SA(b, h) (((b) * 2 + (h)) * HTB)
#define PG8_SB(b, h) ((4 + (b) * 2 + (h)) * HTB)
#define PG8_STAGE(bufoff, gbase, voff) do { _Pragma("unroll") for (int _i = 0; _i < 2; ++_i) \
        __builtin_amdgcn_global_load_lds((const unsigned*)((const char*)(gbase) + (voff)[_i]), (PG8_LAS unsigned*)(lds + (bufoff) + ldsw + _i * 8192), 16, 0, 0); } while (0)
#define PG8_LD2(dst, addr) do { const v4i_t lo_ = *(const PG8_LAS v4i_t*)(addr), hi_ = *(const PG8_LAS v4i_t*)((addr) + 1024); dst = __builtin_shufflevector(lo_, hi_, 0, 1, 2, 3, 4, 5, 6, 7); } while (0)
#define PG8_LDA(dst, b, h) do { _Pragma("unroll") for (int m = 0; m < 4; ++m) PG8_LD2(dst[m], lds + PG8_SA(b, h) + aoff + m * 2048); } while (0)
#define PG8_LDB(dst, b, h) do { _Pragma("unroll") for (int n = 0; n < 2; ++n) PG8_LD2(dst[n], lds + PG8_SB(b, h) + boff + n * 2048); } while (0)
#define PG8_LO(x) __builtin_bit_cast(bf16x8, __builtin_shufflevector(x, x, 0, 1, 2, 3))
#define PG8_HI(x) __builtin_bit_cast(bf16x8, __builtin_shufflevector(x, x, 4, 5, 6, 7))
#define PG8_MMA(ai, bj, At, Bt) do { __builtin_amdgcn_s_setprio(1); _Pragma("unroll") for (int m = 0; m < 4; ++m) _Pragma("unroll") for (int n = 0; n < 2; ++n) { \
        if constexpr (FP8) asm volatile("v_mfma_f32_16x16x128_f8f6f4 %0, %1, %2, %0" : "+v"(acc[ai][bj][m][n]) : "v"(Bt[n]), "v"(At[m]));   \
        else { acc[ai][bj][m][n] = __builtin_amdgcn_mfma_f32_16x16x32_bf16(PG8_LO(Bt[n]), PG8_LO(At[m]), acc[ai][bj][m][n], 0, 0, 0); acc[ai][bj][m][n] = __builtin_amdgcn_mfma_f32_16x16x32_bf16(PG8_HI(Bt[n]), PG8_HI(At[m]), acc[ai][bj][m][n], 0, 0, 0); } } __builtin_amdgcn_s_setprio(0); } while (0)
#define PG8_MMAZ(ai, bj, At, Bt) do { if constexpr (!FP8) { PG8_MMA(ai, bj, At, Bt); } else { __builtin_amdgcn_s_setprio(1);                  \
        asm volatile("s_cmp_eq_u32 %14, 0\n\ts_cbranch_scc1 1f\n\tv_mfma_f32_16x16x128_f8f6f4 %0, %8, %10, 0\n\tv_mfma_f32_16x16x128_f8f6f4 %1, %9, %10, 0\n\tv_mfma_f32_16x16x128_f8f6f4 %2, %8, %11, 0\n\tv_mfma_f32_16x16x128_f8f6f4 %3, %9, %11, 0\n\tv_mfma_f32_16x16x128_f8f6f4 %4, %8, %12, 0\n\tv_mfma_f32_16x16x128_f8f6f4 %5, %9, %12, 0\n\tv_mfma_f32_16x16x128_f8f6f4 %6, %8, %13, 0\n\tv_mfma_f32_16x16x128_f8f6f4 %7, %9, %13, 0\n\ts_branch 2f\n1:\n\tv_mfma_f32_16x16x128_f8f6f4 %0, %8, %10, %0\n\tv_mfma_f32_16x16x128_f8f6f4 %1, %9, %10, %1\n\tv_mfma_f32_16x16x128_f8f6f4 %2, %8, %11, %2\n\tv_mfma_f32_16x16x128_f8f6f4 %3, %9, %11, %3\n\tv_mfma_f32_16x16x128_f8f6f4 %4, %8, %12, %4\n\tv_mfma_f32_16x16x128_f8f6f4 %5, %9, %12, %5\n\tv_mfma_f32_16x16x128_f8f6f4 %6, %8, %13, %6\n\tv_mfma_f32_16x16x128_f8f6f4 %7, %9, %13, %7\n2:"                                                                                                                           \
            : "+v"(acc[ai][bj][0][0]), "+v"(acc[ai][bj][0][1]), "+v"(acc[ai][bj][1][0]), "+v"(acc[ai][bj][1][1]), "+v"(acc[ai][bj][2][0]), "+v"(acc[ai][bj][2][1]), "+v"(acc[ai][bj][3][0]), "+v"(acc[ai][bj][3][1]) \
            : "v"(Bt[0]), "v"(Bt[1]), "v"(At[0]), "v"(At[1]), "v"(At[2]), "v"(At[3]), "s"(zf) : "scc");                                               \
        __builtin_amdgcn_s_setprio(0); } } while (0)
#define PG8_WAIT_V(n) asm volatile("s_waitcnt vmcnt(" #n ")" ::: "memory")
#define PG8_WAIT_L(n) asm volatile("s_waitcnt lgkmcnt(" #n ")" ::: "memory")
#define PG8_BAR __builtin_amdgcn_s_barrier()
#define PG8_SCHED __builtin_amdgcn_sched_barrier(0)
    Unit cur, nxt; int ui = 0;
    if (!S.next(0, cur)) return;
    f32x4 acc[2][2][4][2];
#pragma unroll
    for (int a = 0; a < 2; ++a)
#pragma unroll
        for (int b = 0; b < 2; ++b)
#pragma unroll
            for (int m = 0; m < 4; ++m)
#pragma unroll
                for (int n = 0; n < 2; ++n) { if constexpr (FP8) asm volatile("" : "=v"(acc[a][b][m][n]));   else acc[a][b][m][n] = (f32x4){0.f, 0.f, 0.f, 0.f}; }
    v8i_t At[4], B0[2], B1[2];
    const char* cA = S.a_base(cur); const char* cB = S.b_base(cur);
    if constexpr (GATHER) {
#pragma unroll
        for (int i = 0; i < 2; ++i) { vAc0[i] = S.a_off(0, sR[i]) + (unsigned)sC[i] * 2u; vAc1[i] = S.a_off(0, 128 + sR[i]) + (unsigned)sC[i] * 2u; }
    }
    PG8_STAGE(PG8_SB(0, 0), cB, voffB); PG8_STAGE(PG8_SB(0, 1), cB + hstep, voffB); PG8_STAGE(PG8_SA(0, 0), cA, vAc0); PG8_STAGE(PG8_SA(0, 1), cA + hstepA, vAc1);
    if (wr == 1) PG8_BAR;
    PG8_WAIT_V(2); PG8_BAR;
    PG8_STAGE(PG8_SB(1, 0), cB + kstep, voffB); PG8_STAGE(PG8_SA(1, 0), cA + kstep, vAc0); PG8_STAGE(PG8_SB(1, 1), cB + hstep + kstep, voffB);
    PG8_WAIT_V(6); PG8_BAR;
    PG8_STAGE(PG8_SA(1, 1), cA + kstep + hstepA, vAc1);
    for (;;) {
        E.prefetch(cur, wid, wc, lane);
        const bool has_next = S.next(ui + 1, nxt);
        const char* nA = has_next ? S.a_base(nxt) : cA; const char* nB = has_next ? S.b_base(nxt) : cB;
        if constexpr (GATHER) {
#pragma unroll
            for (int i = 0; i < 2; ++i) { vAn0[i] = has_next ? S.a_off(ui + 1, sR[i]) + (unsigned)sC[i] * 2u : vAc0[i]; vAn1[i] = has_next ? S.a_off(ui + 1, 128 + sR[i]) + (unsigned)sC[i] * 2u : vAc1[i]; }
        }
#define PG8_WAIT_F() asm volatile("s_cmp_eq_u32 %0, 0\n\ts_cbranch_scc0 1f\n\ts_waitcnt vmcnt(8)\n1:\n\ts_waitcnt vmcnt(%1)" ::"s"(first), "n"(8 + Epi::NVM) : "memory", "scc")
        for (int t = 0; t < nt; t += 2) {
            const bool last = (t == nt - 2); const int first = __builtin_amdgcn_readfirstlane((RELAX && t == 0 && ui > 0) ? 1 : 0), zf = __builtin_amdgcn_readfirstlane(t == 0 ? 1 : 0);
            const char* a2 = last ? nA : cA + (size_t)(t + 2) * kstep; const char* b2 = last ? nB : cB + (size_t)(t + 2) * kstep;
            const char* a3 = a2 + kstep; const char* b3 = b2 + kstep;
            unsigned w0[2], w1[2];
#pragma unroll
            for (int i = 0; i < 2; ++i) { w0[i] = (GATHER && last) ? vAn0[i] : vAc0[i]; w1[i] = (GATHER && last) ? vAn1[i] : vAc1[i]; }
            PG8_LDB(B0, 0, 0); PG8_LDB(B1, 0, 1); PG8_SCHED; PG8_LDA(At, 0, 0);
            PG8_WAIT_F(); PG8_WAIT_L(0); PG8_BAR; PG8_MMAZ(0, 0, At, B0); PG8_MMAZ(0, 1, At, B1); PG8_BAR; PG8_SCHED;
            PG8_LDA(At, 0, 1); PG8_STAGE(PG8_SB(0, 0), b2, voffB); PG8_STAGE(PG8_SB(0, 1), b2 + hstep, voffB); PG8_STAGE(PG8_SA(0, 0), a2, w0);
            PG8_WAIT_F(); PG8_WAIT_L(0); PG8_BAR; PG8_MMAZ(1, 0, At, B0); PG8_MMAZ(1, 1, At, B1); PG8_BAR; PG8_SCHED;
            PG8_LDB(B0, 1, 0); PG8_LDB(B1, 1, 1); PG8_SCHED; PG8_LDA(At, 1, 0); PG8_STAGE(PG8_SA(0, 1), a2 + hstepA, w1);
            PG8_WAIT_F(); PG8_WAIT_L(0); PG8_BAR; PG8_MMA(0, 0, At, B0); PG8_MMA(0, 1, At, B1); PG8_BAR; PG8_SCHED;
            PG8_LDA(At, 1, 1); PG8_STAGE(PG8_SB(1, 0), b3, voffB); PG8_STAGE(PG8_SB(1, 1), b3 + hstep, voffB); PG8_STAGE(PG8_SA(1, 0), a3, w0);
            PG8_WAIT_V(8); PG8_WAIT_L(0); PG8_BAR; PG8_MMA(1, 0, At, B0); PG8_MMA(1, 1, At, B1); PG8_BAR; PG8_SCHED;
            PG8_STAGE(PG8_SA(1, 1), a3 + hstepA, w1);
        }
        if constexpr (ALIGN_EPI) { if (wr == 0) PG8_BAR; }
        if constexpr (FP8) { asm volatile("s_nop 15\n\ts_nop 15\n\ts_nop 15" ::: "memory"); }
        E(acc, cur, wr, wc, fr, fq);
        if (!has_next) break;
        if constexpr (!FP8) {
#pragma unroll
        for (int a = 0; a < 2; ++a)
#pragma unroll
            for (int b = 0; b < 2; ++b)
#pragma unroll
                for (int m = 0; m < 4; ++m)
#pragma unroll
                    for (int n = 0; n < 2; ++n) acc[a][b][m][n] = (f32x4){0.f, 0.f, 0.f, 0.f};
        }
        cur = nxt; cA = nA; cB = nB; ++ui;
        if constexpr (GATHER) {
#pragma unroll
            for (int i = 0; i < 2; ++i) { vAc0[i] = vAn0[i]; vAc1[i] = vAn1[i]; }
        }
        if constexpr (ALIGN_EPI) { if (wr == 1) PG8_BAR; }
    }
    PG8_WAIT_V(0);
    if constexpr (!ALIGN_EPI) { if (wr == 0) PG8_BAR; }
    PG8_BAR;
#undef PG8_SA
#undef PG8_SB
#undef PG8_STAGE
#undef PG8_LDA
#undef PG8_LDB
#undef PG8_MMA
#undef PG8_MMAZ
#undef PG8_LO
#undef PG8_HI
#undef PG8_LD2
#undef PG8_WAIT_V
#undef PG8_WAIT_F
#undef PG8_WAIT_L
#undef PG8_BAR
#undef PG8_SCHED
}

struct EpiInProj {
    static constexpr bool PERM = true; static constexpr int NVM = 16;
    bf16_t* Q; size_t qkv_stride; bf16_t* PCG; float* kmean; float scale;
    __device__ __forceinline__ void prefetch(const Unit&, int, int, int) const {}
    __device__ __forceinline__ void operator()(const f32x4 (&acc)[2][2][4][2], const Unit& u, int wr, int wc, int fr, int fq) const {
        const int b = u.pm >> 3, sblk = u.pm & 7, dcol = wc * 32 + 8 * PG8_PQ(fq);
        if (u.pn < 12) {
            const int which = u.pn >> 2; bf16_t* base = Q + (size_t)which * qkv_stride;
#pragma unroll
            for (int bj = 0; bj < 2; ++bj) { const int head = (u.pn & 3) * 2 + bj;
                bf16_t* hp = base + ((size_t)(b * 8 + head) * 2048 + sblk * 256 + wr * 64 + fr) * 128 + dcol;
#pragma unroll
                for (int ai = 0; ai < 2; ++ai)
#pragma unroll
                    for (int m = 0; m < 4; ++m) { const f32x4 v0 = acc[ai][bj][m][0] * scale, v1 = acc[ai][bj][m][1] * scale; u32x4 w;
                        w.x = cvt_pk_bf16(v0[0], v0[1]); w.y = cvt_pk_bf16(v0[2], v0[3]); w.z = cvt_pk_bf16(v1[0], v1[1]); w.w = cvt_pk_bf16(v1[2], v1[3]);
                        *(u32x4*)(hp + (size_t)(ai * 128 + m * 16) * 128) = w; }
                if (which == 1) {
#pragma unroll
                    for (int n = 0; n < 2; ++n) { f32x4 cs = (f32x4){0.f, 0.f, 0.f, 0.f};
#pragma unroll
                        for (int ai = 0; ai < 2; ++ai)
#pragma unroll
                            for (int m = 0; m < 4; ++m) cs += acc[ai][bj][m][n];
#pragma unroll
                        for (int q = 0; q < 4; ++q) { float v = cs[q] * scale; v += __shfl_xor(v, 1); v += __shfl_xor(v, 2); v += __shfl_xor(v, 4); v += __shfl_xor(v, 8);
                            if (fr == 0) __hip_atomic_fetch_add(kmean + ((size_t)(b * 8 + head) * 8 + sblk) * 128 + dcol + 4 * n + q, v, __ATOMIC_RELAXED, __HIP_MEMORY_SCOPE_AGENT); } }
                }
            }
        } else {
            const int col0 = (u.pn - 12) * 256 + dcol;
#pragma unroll
            for (int ai = 0; ai < 2; ++ai)
#pragma unroll
                for (int m = 0; m < 4; ++m) { bf16_t* rowp = PCG + (size_t)(u.pm * 256 + ai * 128 + wr * 64 + m * 16 + fr) * 2048 + col0;
#pragma unroll
                    for (int bj = 0; bj < 2; ++bj) { const f32x4 v0 = acc[ai][bj][m][0] * scale, v1 = acc[ai][bj][m][1] * scale; u32x4 w;
                        w.x = cvt_pk_bf16(v0[0], v0[1]); w.y = cvt_pk_bf16(v0[2], v0[3]); w.z = cvt_pk_bf16(v1[0], v1[1]); w.w = cvt_pk_bf16(v1[2], v1[3]);
                        *(u32x4*)(rowp + bj * 128) = w; } }
        }
    }
};
struct EpiPlain {
    static constexpr bool PERM = true; static constexpr int NVM = 16;
    bf16_t* O; int ldc; const float* bias; float scale;
    __device__ __forceinline__ void prefetch(const Unit&, int, int, int) const {}
    __device__ __forceinline__ void operator()(const f32x4 (&acc)[2][2][4][2], const Unit& u, int wr, int wc, int fr, int fq) const {
        const int col0 = u.pn * 256 + wc * 32 + 8 * PG8_PQ(fq);
        f32x4 bv[2][2];
#pragma unroll
        for (int bj = 0; bj < 2; ++bj)
#pragma unroll
            for (int n = 0; n < 2; ++n) bv[bj][n] = bias ? *(const f32x4*)(bias + (size_t)u.e * 2048 + col0 + bj * 128 + 4 * n) : (f32x4){0.f, 0.f, 0.f, 0.f};
#pragma unroll
        for (int ai = 0; ai < 2; ++ai)
#pragma unroll
            for (int m = 0; m < 4; ++m) { bf16_t* rowp = O + (size_t)(u.pm * 256 + ai * 128 + wr * 64 + m * 16 + fr) * ldc + col0;
#pragma unroll
                for (int bj = 0; bj < 2; ++bj) { const f32x4 v0 = acc[ai][bj][m][0] * scale + bv[bj][0], v1 = acc[ai][bj][m][1] * scale + bv[bj][1]; u32x4 w;
                    w.x = cvt_pk_bf16(v0[0], v0[1]); w.y = cvt_pk_bf16(v0[2], v0[3]); w.z = cvt_pk_bf16(v1[0], v1[1]); w.w = cvt_pk_bf16(v1[2], v1[3]);
                    *(u32x4*)(rowp + bj * 128) = w; } }
    }
};
struct EpiPlain8 {
    static constexpr bool PERM = true; static constexpr int NVM = 9;
    unsigned char* O; const float* bias; float scale; PG8_LAS float* bl;
    __device__ __forceinline__ void prefetch(const Unit& u, int wid, int wc, int lane) const {
        __builtin_amdgcn_global_load_lds((const unsigned*)(bias + (size_t)u.e * 2048 + u.pn * 256 + wc * 32 + (lane >> 5) * 128 + (lane & 31)), (PG8_LAS unsigned*)(bl + wid * 64), 4, 0, 0); }
    __device__ __forceinline__ void operator()(const f32x4 (&acc)[2][2][4][2], const Unit& u, int wr, int wc, int fr, int fq) const {
        const int col0 = u.pn * 256 + wc * 32 + 8 * PG8_PQ(fq);
        const PG8_LAS float* bs = bl + (wr * 4 + wc) * 64 + 8 * PG8_PQ(fq);
        f32x4 bv[2][2];
#pragma unroll
        for (int bj = 0; bj < 2; ++bj)
#pragma unroll
            for (int n = 0; n < 2; ++n) bv[bj][n] = *(const PG8_LAS f32x4*)(bs + bj * 32 + 4 * n);
        const bool up_ = fq >= 2; const int cst = up_ ? col0 + 128 - 8 : col0;
#pragma unroll
        for (int ai = 0; ai < 2; ++ai)
#pragma unroll
            for (int m = 0; m < 4; ++m) { unsigned char* rowp = O + (size_t)(u.pm * 256 + ai * 128 + wr * 64 + m * 16 + fr) * 2048 + cst;
                v2u w[2];
#pragma unroll
                for (int bj = 0; bj < 2; ++bj) { const f32x4 v0 = acc[ai][bj][m][0] * scale + bv[bj][0], v1 = acc[ai][bj][m][1] * scale + bv[bj][1];
                    w[bj].x = pk4_fp8(v0[0], v0[1], v0[2], v0[3]); w[bj].y = pk4_fp8(v1[0], v1[1], v1[2], v1[3]); }
                const auto rx = __builtin_amdgcn_permlane32_swap(w[0].x, w[1].x, false, false), ry = __builtin_amdgcn_permlane32_swap(w[0].y, w[1].y, false, false);
                *(u32x4*)rowp = (u32x4){rx[0], ry[0], rx[1], ry[1]}; }
    }
};
__device__ __forceinline__ f32x4 swiglu4(f32x4 g, f32x4 u1) {
    f32x4 e, r;
#pragma unroll
    for (int q = 0; q < 4; ++q) { g[q] = __builtin_fminf(g[q], 7.f); u1[q] = __builtin_amdgcn_fmed3f(u1[q], -6.f, 8.f); }
    const f32x4 a = g * (-1.702f * 1.4426950408889634f);
#pragma unroll
    for (int q = 0; q < 4; ++q) e[q] = __builtin_amdgcn_exp2f(a[q]);
    const f32x4 d = e + 1.f;
#pragma unroll
    for (int q = 0; q < 4; ++q) r[q] = __builtin_amdgcn_rcpf(d[q]);
    return (g * r) * u1;
}
__device__ __forceinline__ unsigned pk4_fp8_nc(f32x4 v) {
    const unsigned w = __builtin_amdgcn_cvt_pk_fp8_f32(v[0], v[1], 0, false); return __builtin_amdgcn_cvt_pk_fp8_f32(v[2], v[3], w, true); }
struct EpiGU {
    static constexpr bool PERM = true; static constexpr int NVM = 5;
    unsigned char* act; const float* bg; const float* bu; float scale; PG8_LAS float* bl;
    __device__ __forceinline__ void prefetch(const Unit& u, int wid, int wc, int lane) const {
        __builtin_amdgcn_global_load_lds((const unsigned*)((lane < 32 ? bg : bu) + (size_t)u.e * 1024 + u.pn * 128 + wc * 32 + (lane & 31)), (PG8_LAS unsigned*)(bl + wid * 64), 4, 0, 0); }
    __device__ __forceinline__ void operator()(const f32x4 (&acc)[2][2][4][2], const Unit& u, int wr, int wc, int fr, int fq) const {
        const int j0 = u.pn * 128 + wc * 32 + 8 * PG8_PQ(fq);
        const PG8_LAS float* bs = bl + (wr * 4 + wc) * 64 + 8 * PG8_PQ(fq);
        f32x4 gv[2], uv[2];
#pragma unroll
        for (int n = 0; n < 2; ++n) { gv[n] = *(const PG8_LAS f32x4*)(bs + 4 * n); uv[n] = *(const PG8_LAS f32x4*)(bs + 32 + 4 * n) + 1.f; }
        const bool up_ = fq >= 2; const int cst = up_ ? j0 - 8 : j0;
#pragma unroll
        for (int ai = 0; ai < 2; ++ai)
#pragma unroll
            for (int mp = 0; mp < 2; ++mp) { v2u w[2];
#pragma unroll
                for (int mm = 0; mm < 2; ++mm) { const int m = 2 * mp + mm;
                    w[mm].x = pk4_fp8_nc(swiglu4(acc[ai][0][m][0] * scale + gv[0], acc[ai][1][m][0] * scale + uv[0]));
                    w[mm].y = pk4_fp8_nc(swiglu4(acc[ai][0][m][1] * scale + gv[1], acc[ai][1][m][1] * scale + uv[1])); }
                const auto rx = __builtin_amdgcn_permlane32_swap(w[0].x, w[1].x, false, false), ry = __builtin_amdgcn_permlane32_swap(w[0].y, w[1].y, false, false);
                *(u32x4*)(act + (size_t)(u.pm * 256 + ai * 128 + wr * 64 + (2 * mp + (up_ ? 1 : 0)) * 16 + fr) * 1024 + cst) = (u32x4){rx[0], ry[0], rx[1], ry[1]}; }
    }
};
}

#define XB_TMO      128
#define XB_XCNT(j)  (256  + 64 * (j))
#define XB_XSUB(j)  (1280 + 64 * (j))
#define XB_XGEN(j)  (2304 + 64 * (j))
#define XB_TOP      3328
#define XB_TOPGEN   3392
#define XB_SPIN_CAP (1u << 18)
__device__ __forceinline__ unsigned xb_ld(unsigned* p)              { return __hip_atomic_load(p, __ATOMIC_RELAXED, __HIP_MEMORY_SCOPE_AGENT); }
__device__ __forceinline__ unsigned xb_add(unsigned* p, unsigned v) { return __hip_atomic_fetch_add(p, v, __ATOMIC_RELAXED, __HIP_MEMORY_SCOPE_AGENT); }
__device__ __forceinline__ unsigned xb_xcc_id() { return (unsigned)__builtin_amdgcn_s_getreg((3 << 11) | 20) & 0xFu; }
#define XB_SPIN(cond, bar) do { unsigned _sp = 0; while (cond) { __builtin_amdgcn_s_sleep(1); \
    if ((++_sp & 255u) == 0u) { if (xb_ld(&(bar)[XB_TMO])) break; if (_sp > XB_SPIN_CAP) { atomicAdd(&(bar)[XB_TMO], 1u); break; } } } } while (0)
struct XcdBarrier { unsigned* bar; unsigned x; volatile LAS unsigned* st; };
__device__ __forceinline__ XcdBarrier xcd_barrier_post(unsigned* bar, volatile LAS unsigned* st) {
    XcdBarrier b; b.bar = bar; b.x = xb_xcc_id(); b.st = st;
    if (threadIdx.x == 0) (void)xb_add(&bar[XB_XCNT(b.x)], 1u);
    return b;
}
__device__ __forceinline__ void xcd_barrier_complete(unsigned* bar, unsigned x, unsigned& nloc, unsigned& nx) {
    const unsigned G = gridDim.x * gridDim.y * gridDim.z;
    unsigned sum, cnt, mine, sp = 0u;
    for (;;) {
        sum = 0u; cnt = 0u; mine = 0u;
#pragma unroll
        for (unsigned j = 0; j < 16; ++j) { const unsigned c = xb_ld(&bar[XB_XCNT(j)]); sum += c; cnt += (c > 0u) ? 1u : 0u; mine = (j == x) ? c : mine; }
        if (sum == G) break;
        __builtin_amdgcn_s_sleep(1);
        if ((++sp & 255u) == 0u) { if (xb_ld(&bar[XB_TMO])) break; if (sp > XB_SPIN_CAP) { atomicAdd(&bar[XB_TMO], 1u); break; } }
    }
    nloc = mine > 0u ? mine : 1u; nx = cnt > 0u ? cnt : 1u;
}
__device__ __forceinline__ void xcd_barrier(const XcdBarrier& b) {
    asm volatile("s_waitcnt vmcnt(0)" ::: "memory");
    __syncthreads();
    if (threadIdx.x == 0) {
        unsigned* bar = b.bar;
        __builtin_amdgcn_s_waitcnt(0);
        unsigned nloc = b.st[0], nx = b.st[1];
        if (nloc == 0u) { xcd_barrier_complete(bar, b.x, nloc, nx); b.st[0] = nloc; b.st[1] = nx; }
        const unsigned old = xb_add(&bar[XB_XSUB(b.x)], 1u);
        const unsigned gen = old / nloc;
        if (old + 1u == (gen + 1u) * nloc) {
            __builtin_amdgcn_fence(__ATOMIC_RELEASE, "agent");
            asm volatile("s_waitcnt vmcnt(0)" ::: "memory");
            const unsigned og = xb_add(&bar[XB_TOP], 1u);
            const unsigned tg = og / nx;
            if (og + 1u == (tg + 1u) * nx) xb_add(&bar[XB_TOPGEN], 1u);
            else XB_SPIN(xb_ld(&bar[XB_TOPGEN]) == tg, bar);
            __builtin_amdgcn_fence(__ATOMIC_ACQUIRE, "agent");
            xb_add(&bar[XB_XGEN(b.x)], 1u);
            asm volatile("s_waitcnt vmcnt(0)" ::: "memory");
        } else {
            XB_SPIN(xb_ld(&bar[XB_XGEN(b.x)]) == gen, bar);
            __builtin_amdgcn_fence(__ATOMIC_ACQUIRE, "agent");
            asm volatile("s_waitcnt vmcnt(0)" ::: "memory");
        }
    }
    __syncthreads();
}

struct Args { const float* in[22]; float* out; unsigned char* ws; int ph_lo, ph_hi, li, pad; };
enum { I_X = 0, I_C, I_WADA, I_BADA, I_GPREM, I_GPOSTM, I_GPREF, I_GPOSTF, I_WIN, I_WOUT, I_POOLW, I_POOLS, I_CONVW, I_RELB, I_RW, I_RB, I_WG, I_BG, I_WU, I_BU, I_WD, I_BD };

__device__ __forceinline__ float wave_sum(float v) {
#pragma unroll
    for (int o = 1; o < 64; o <<= 1) v += __shfl_xor(v, o);
    return v;
}
__device__ __forceinline__ float wave_max(float v) {
#pragma unroll
    for (int o = 1; o < 64; o <<= 1) v = fmaxf(v, __shfl_xor(v, o));
    return v;
}
__device__ __forceinline__ float silu(float x) { return x / (1.f + __expf(-x)); }

template <int NSET>
__device__ __forceinline__ void weight_transposes(const Args& a, LAS unsigned char* lds, int gw, int NGW, int wave, int lane_in, int lE, int lP) {
    int lane = lane_in; asm volatile("" : "+v"(lane));
    unsigned char* ws = a.ws;
    constexpr int SU_G = NE * 8 * 32, SU_D = NE * 4 * 64, SU_O = 8 * 64, SU_I = 8 * 144;
    const int SU_E = lE >= 0 ? 2 * SU_G + SU_D : 0, SU_ALL = SU_E + (lP >= 0 ? SU_O + SU_I : 0);
    struct SDesc { const float* src; unsigned char* dst; int N, pitch; };
    auto decode = [&](int it) -> SDesc {
        SDesc d; int r = it;
        if (r < SU_E) {
        if (r < 2 * SU_G) { const int up = r >= SU_G; if (up) r -= SU_G;
            const int nb = r & 31, kq = (r >> 5) & 7, le = lE * NE + (r >> 8), n0 = nb * 32, k0 = kq * 256;
            d.src = a.in[up ? I_WU : I_WG] + (size_t)le * D * DE + (size_t)k0 * DE + n0; d.N = DE; d.pitch = D;
            d.dst = ws + WS_WGU + ((size_t)le * 2048 + (n0 >> 7) * 256 + up * 128 + (n0 & 127)) * D + k0; return d; }
        r -= 2 * SU_G;
        { const int nb = r & 63, kq = (r >> 6) & 3, le = lE * NE + (r >> 8), n0 = nb * 32, k0 = kq * 256;
            d.src = a.in[I_WD] + (size_t)le * DE * D + (size_t)k0 * D + n0; d.N = D; d.pitch = DE;
            d.dst = ws + WS_WDN + ((size_t)le * 2048 + n0) * DE + k0; return d; } }
        r -= SU_E; const int l = lP;
        if (r < SU_O) { const int nb = r & 63, kq = (r >> 6) & 7, n0 = nb * 32, k0 = kq * 256;
            d.src = a.in[I_WOUT] + (size_t)l * D * D + (size_t)k0 * D + n0; d.N = D; d.pitch = D;
            d.dst = ws + WS_WOUT + ((size_t)l * D + n0) * D + k0; return d; }
        r -= SU_O;
        { const int nq = r % 144, nb = nq < 96 ? nq : nq + 16, kq = r / 144, n0 = nb * 32, k0 = kq * 256;
            d.src = a.in[I_WIN] + (size_t)l * D * DIN + (size_t)k0 * DIN + n0; d.N = DIN; d.pitch = D;
            d.dst = ws + WS_WIN + ((size_t)l * DIN + n0) * D + k0; return d; }
    };
    LAS unsigned char* wb = lds + wave * 16384;
#define SU_LOAD(R, d, sub) do { const unsigned lo_ = (unsigned)(((lane >> 3) * 16 * (d).N + (lane & 7) * 4) * 4);     \
        const char* sb_ = (const char*)((d).src + (size_t)((sub) * 128) * (d).N);                                                                    \
        _Pragma("unroll") for (int j = 0; j < 16; ++j) R[j] = __builtin_nontemporal_load((const f32x4*)(sb_ + (size_t)j * (d).N * 4 + lo_)); } while (0)
#define SU_CONV(R, sub) do { const int r_ = lane >> 3, c4_ = lane & 7;                                                                               \
        _Pragma("unroll") for (int i = 0; i < 4; ++i) { v4u o;                                                                                       \
            o.x = pk4_fp8(R[0][i] * WSCALE, R[1][i] * WSCALE, R[2][i] * WSCALE, R[3][i] * WSCALE); o.y = pk4_fp8(R[4][i] * WSCALE, R[5][i] * WSCALE, R[6][i] * WSCALE, R[7][i] * WSCALE);          \
            o.z = pk4_fp8(R[8][i] * WSCALE, R[9][i] * WSCALE, R[10][i] * WSCALE, R[11][i] * WSCALE); o.w = pk4_fp8(R[12][i] * WSCALE, R[13][i] * WSCALE, R[14][i] * WSCALE, R[15][i] * WSCALE);     \
            *(LAS v4u*)(wb + (c4_ * 4 + i) * 256 + ((((sub) * 8 + r_) ^ c4_) << 4)) = o; } } while (0)
#define SU_OUT(d) do { LDS_WAIT(); asm volatile("" ::: "memory");                                                                                    \
        _Pragma("unroll") for (int q8 = 0; q8 < 8; ++q8) { const int n_ = 4 * q8 + (lane >> 4), c_ = lane & 15;                                     \
            __builtin_nontemporal_store(*(const LAS v4u*)(wb + n_ * 256 + ((c_ ^ ((n_ >> 2) & 7)) << 4)), (v4u*)((d).dst + (size_t)n_ * (d).pitch + c_ * 16)); }                \
        LDS_WAIT(); asm volatile("" ::: "memory"); } while (0)
    if (gw < SU_ALL) {
        const int n2 = 2 * ((SU_ALL - gw + NGW - 1) / NGW);
#define SU_LDQ(R, q) do { if ((q) < n2) { const SDesc d_ = decode(gw + ((q) >> 1) * NGW); SU_LOAD(R, d_, (q) & 1); } asm volatile("" ::: "memory"); } while (0)
#define SU_CVQ(R, q) do { if ((q) < n2) { SU_CONV(R, (q) & 1); if ((q) & 1) { const SDesc d_ = decode(gw + ((q) >> 1) * NGW); SU_OUT(d_); } } asm volatile("" ::: "memory"); } while (0)
        f32x4 RA[16], RB[16];
        if constexpr (NSET == 3) {
            f32x4 RC[16];
            SU_LDQ(RA, 0); SU_LDQ(RB, 1);
            for (int q = 0; q < n2; q += 3) {
                SU_LDQ(RC, q + 2); SU_CVQ(RA, q);
                SU_LDQ(RA, q + 3); SU_CVQ(RB, q + 1);
                SU_LDQ(RB, q + 4); SU_CVQ(RC, q + 2);
            }
        } else {
            SU_LDQ(RA, 0);
            for (int q = 0; q < n2; q += 2) {
                SU_LDQ(RB, q + 1); SU_CVQ(RA, q);
                SU_LDQ(RA, q + 2); SU_CVQ(RB, q + 1);
            }
        }
#undef SU_LDQ
#undef SU_CVQ
    }
#undef SU_LOAD
#undef SU_CONV
#undef SU_OUT
}
__device__ __forceinline__ void p0a(const Args& a, LAS unsigned char* lds, int gw, int NGW, int wave, int lane, int tid) {
    unsigned char* ws = a.ws;
    LAS float* scr = (LAS float*)(lds + wave * 8448);
    LAS float* cact = (LAS float*)lds;
    for (int i = tid; i < 8 * D; i += NWAVES * 64) cact[i] = silu(a.in[I_C][i]);
    __syncthreads();
    for (int it = gw; it < NL * 48 * 16; it += NGW) {
        const int kc = it & 15, nb = (it >> 4) % 48, l = it / (16 * 48);
        const float* W = a.in[I_WADA] + ((size_t)l * D + kc * 128) * NMOD + nb * 256 + lane * 4;
        f32x4 acc[8];
#pragma unroll
        for (int b = 0; b < 8; ++b) acc[b] = (f32x4){0.f, 0.f, 0.f, 0.f};
#pragma unroll 8
        for (int kk = 0; kk < 128; ++kk) { const f32x4 w = *(const f32x4*)(W + (size_t)kk * NMOD);
#pragma unroll
            for (int b = 0; b < 8; ++b) acc[b] += w * cact[b * D + kc * 128 + kk]; }
        float* P = (float*)(ws + WS_MODP) + (((size_t)kc * NL + l) * 8) * NMOD + nb * 256 + lane * 4;
#pragma unroll
        for (int b = 0; b < 8; ++b) *(f32x4*)(P + (size_t)b * NMOD) = acc[b];
    }
    __syncthreads();
    for (int it = gw; it < NL * 4 * 32 * 4; it += NGW) {
        const int jb = it & 3, kb = (it >> 2) & 31, g = (it >> 7) & 3, l = it >> 9;
        const float* Wi = a.in[I_WIN] + ((size_t)l * D + kb * 64 + lane) * DIN + 3072 + g * 128;
        const float* Wp = a.in[I_POOLW] + ((size_t)(l * 4 + g) * 128) * 128 + jb * 32;
        LAS float* wl = (LAS float*)(lds + wave * 16384);
#pragma unroll
        for (int q = 0; q < 16; ++q) { const int c = q * 8 + (lane >> 3), jj = (lane & 7) * 4; *(LAS f32x4*)(wl + c * 32 + jj) = *(const f32x4*)(Wp + (size_t)c * 128 + jj); }
        LDS_WAIT(); asm volatile("" ::: "memory");
        float acc[32];
#pragma unroll
        for (int j2 = 0; j2 < 32; ++j2) acc[j2] = 0.f;
#pragma unroll 4
        for (int c4 = 0; c4 < 32; ++c4) { const f32x4 av = *(const f32x4*)(Wi + 4 * c4);
#pragma unroll
            for (int cc = 0; cc < 4; ++cc) {
#pragma unroll
                for (int j4 = 0; j4 < 8; ++j4) { const f32x4 wv = *(const LAS f32x4*)(wl + (4 * c4 + cc) * 32 + 4 * j4);
                    acc[4 * j4 + 0] += av[cc] * wv.x; acc[4 * j4 + 1] += av[cc] * wv.y; acc[4 * j4 + 2] += av[cc] * wv.z; acc[4 * j4 + 3] += av[cc] * wv.w; } } }
        unsigned char* WT = ws + WS_WIN + ((size_t)l * DIN + 3072 + g * 128 + jb * 32) * D + kb * 64 + lane;
        const float* ps = a.in[I_POOLS] + l * 512 + g * 128 + jb * 32;
#pragma unroll
        for (int j2 = 0; j2 < 32; ++j2) WT[(size_t)j2 * D] = (unsigned char)(pk4_fp8(acc[j2] * ps[j2] * WSCALE, 0.f, 0.f, 0.f) & 0xffu);
        LDS_WAIT(); asm volatile("" ::: "memory");
    }
    for (int i = gw * 64 + lane; i < NL * NE * D; i += NGW * 64) { const int k = i & 2047, n = (i >> 11) & 31, l = i >> 16;
        ((bf16*)(ws + WS_WR))[i] = (bf16)f2bf(a.in[I_RW][((size_t)l * D + k) * NE + n]); }
    weight_transposes<2>(a, lds, gw, NGW, wave, lane, -1, 0);
}
__device__ __forceinline__ void p0b(const Args& a, int gw, int NGW, int lane) {
    const float* P = (const float*)(a.ws + WS_MODP); float* mod = (float*)(a.ws + WS_MOD);
    for (int i = gw * 64 + lane; i < NL * 8 * NMOD; i += NGW * 64) {
        const int n = i % NMOD, l = i / (8 * NMOD);
        float s = a.in[I_BADA][(size_t)l * NMOD + n];
#pragma unroll
        for (int kc = 0; kc < 16; ++kc) s += P[(size_t)kc * NL * 8 * NMOD + i];
        const int ch = n / D, c = n - ch * D;
        if (ch == 1) s = a.in[I_GPREM][l * D + c] * (1.f + s); else if (ch == 2) s *= a.in[I_GPOSTM][l * D + c];
        else if (ch == 4) s = a.in[I_GPREF][l * D + c] * (1.f + s); else if (ch == 5) s *= a.in[I_GPOSTF][l * D + c];
        mod[i] = s;
    }
}
__device__ __forceinline__ void prenorm_store(const f32x4 (&v)[8], const float* gb, const float* sh, bf16* orow, int lane) {
    float ss = 0.f;
#pragma unroll
    for (int j = 0; j < 8; ++j) ss += (v[j].x * v[j].x + v[j].y * v[j].y) + (v[j].z * v[j].z + v[j].w * v[j].w);
    const float r = rsqrtf(wave_sum(ss) * (1.f / D) + EPS);
#pragma unroll
    for (int j = 0; j < 8; ++j) { const int c = 256 * j + 4 * lane;
        const f32x4 h = v[j] * r * *(const f32x4*)(gb + c) + *(const f32x4*)(sh + c);
        v2u o; o.x = pk2(h.x, h.y); o.y = pk2(h.z, h.w);
        *(v2u*)(orow + c) = o; }
}
__device__ __forceinline__ void prenorm_store_lds(const f32x4 (&v)[8], const LAS float* gb, const LAS float* sh, unsigned char* orow, int lane) {
    float ss = 0.f;
#pragma unroll
    for (int j = 0; j < 8; ++j) ss += (v[j].x * v[j].x + v[j].y * v[j].y) + (v[j].z * v[j].z + v[j].w * v[j].w);
    const float r = rsqrtf(wave_sum(ss) * (1.f / D) + EPS);
#pragma unroll
    for (int j = 0; j < 8; ++j) { const int c = 256 * j + 4 * lane;
        const f32x4 h = v[j] * r * *(const LAS f32x4*)(gb + c) + *(const LAS f32x4*)(sh + c);
        *(unsigned*)(orow + c) = pk4_fp8(h.x, h.y, h.z, h.w); }
}
__device__ __forceinline__ void p0c(const Args& a, LAS unsigned char* lds, int gw, int NGW, int lane, int tid) {
    const int rpw = (T + NGW - 1) / NGW, t_first = (gw - (tid >> 6)) * rpw, bA = (t_first < T ? t_first : T - 1) / S;
    LAS float* prm = (LAS float*)lds;
    { const float* P = (const float*)(a.ws + WS_MODP);
      for (int i = tid; i < 2 * 2 * D; i += NWAVES * 64) { const int bb = i / (2 * D), n = i - bb * 2 * D; int b = bA + bb; b = b < NB ? b : NB - 1;
          float sacc = a.in[I_BADA][n];
#pragma unroll
          for (int kc = 0; kc < 16; ++kc) sacc += P[((size_t)kc * NL * 8 + b) * NMOD + n];
          if (n >= D) sacc = a.in[I_GPREM][n - D] * (1.f + sacc);
          prm[i] = sacc; } }
    __syncthreads();
    for (int t0 = gw * rpw; t0 < (gw + 1) * rpw && t0 < T; t0 += 2) {
        f32x4 v[2][8];
#pragma unroll
        for (int q = 0; q < 2; ++q) { const int t = (t0 + q < T && t0 + q < (gw + 1) * rpw) ? t0 + q : t0;
#pragma unroll
            for (int j = 0; j < 8; ++j) v[q][j] = *(const f32x4*)(a.in[I_X] + (size_t)t * D + 256 * j + 4 * lane); }
#pragma unroll
        for (int q = 0; q < 2; ++q) if (t0 + q < T && t0 + q < (gw + 1) * rpw) { const int t = t0 + q; const LAS float* mb = prm + (t / S - bA) * 2 * D;
#pragma unroll
            for (int j = 0; j < 8; ++j) { v2u o; o.x = pk2(v[q][j].x, v[q][j].y); o.y = pk2(v[q][j].z, v[q][j].w); *(v2u*)((bf16*)(a.ws + WS_XB) + (size_t)t * D + 256 * j + 4 * lane) = o; }
            prenorm_store_lds(v[q], mb + D, mb, a.ws + WS_HB + (size_t)t * D, lane); }
    }
}


__device__ __forceinline__ void grouped_prepare(LAS unsigned char* lds, const int* __restrict__ counts, const int* __restrict__ rowtok, bool gather, int G, int c, pg8::GroupedOrder& So) {
    LAS int* tstart = (LAS int*)(lds + LX_TSTART); LAS int* cnt = (LAS int*)(lds + LX_CNT); LAS int* tile_e = (LAS int*)(lds + LX_TILEE); LAS int* idx = (LAS int*)(lds + LX_IDX);
    int tid_l = threadIdx.x; asm volatile("" : "+v"(tid_l));
    const int tid = tid_l;
    __syncthreads();
    if (tid < NE) cnt[tid] = counts[tid];
    __syncthreads();
    if (tid == 0) { int s = 0; for (int e = 0; e < NE; ++e) { tstart[e] = s; s += (cnt[e] + 255) >> 8; } tstart[NE] = s; }
    __syncthreads();
    const int ntiles = tstart[NE];
    for (int g = tid; g < ntiles; g += NWAVES * 64) { int e = 0; for (int k = 1; k < NE; ++k) e = (tstart[k] <= g) ? k : e; tile_e[g] = e; }
    __syncthreads();
    So.ntiles = ntiles; So.G = G; So.c = c; So.tile_e = tile_e; So.idx = idx;
    if (gather) {
        for (int i = 0; i < 10; ++i) { pg8::Unit u; if (!So.next(i, u)) break;
            if (tid < 256) { const int grow = (u.pm - tstart[u.e]) * 256 + tid; idx[i * 256 + tid] = (grow < cnt[u.e]) ? rowtok[(size_t)u.e * T + grow] : 0; } }
    }
    __syncthreads();
}

__device__ __forceinline__ void top4_rows(LAS float* LOGIT, int row, int (&ix)[4], float (&gt)[4]) {
    float v[4];
#pragma unroll
    for (int j = 0; j < 4; ++j) { int best = 0; float bv = -3e38f;
        for (int n = 0; n < NE; ++n) { const float x = LOGIT[row * 32 + n]; if (x > bv) { bv = x; best = n; } }
        v[j] = bv; ix[j] = best; LOGIT[row * 32 + best] = -3.4e38f; }
    float sum = 0.f;
#pragma unroll
    for (int j = 0; j < 4; ++j) { gt[j] = __expf(v[j] - v[0]); sum += gt[j]; }
    const float inv = 1.f / sum;
#pragma unroll
    for (int j = 0; j < 4; ++j) gt[j] *= inv;
}
__device__ __forceinline__ void row1_phase(const Args& a, LAS unsigned char* lds, int l, int G, int bx) {
    int tid_l = threadIdx.x; asm volatile("" : "+v"(tid_l));
    const int tid = tid_l, lane = tid & 63, wave = __builtin_amdgcn_readfirstlane(tid >> 6);
    unsigned char* ws = a.ws;
    const bf16* xinb = (const bf16*)(ws + WS_XB);
    const bf16* mix = (const bf16*)(ws + WS_MIX); unsigned char* hb8 = ws + WS_HB8;
    bf16* xo = (bf16*)(ws + WS_XB);
    const float* modl = (const float*)(ws + WS_MOD) + (size_t)l * 8 * NMOD;
    int* topi = (int*)(ws + WS_ROUT); float* topg = (float*)(ws + WS_ROUT + 256 * 1024); int* toprank = (int*)(ws + WS_ROUT + 512 * 1024);
    int* rowtok = (int*)(ws + WS_ROWTOK); int* counts = (int*)(ws + WS_CTL) + CW_COUNTS + l * 32;
    LAS bf16* H2T = (LAS bf16*)lds;
    LAS float* PART = (LAS float*)(lds + 66048); LAS float* LOGIT = (LAS float*)(lds + 82432);
    LAS int* TOPI_L = (LAS int*)(lds + 84480); LAS int* LR_L = TOPI_L + 512; LAS int* LHIST = LR_L + 512; LAS int* LBASE = LHIST + 32;
    const bf16* Wr = (const bf16*)(ws + WS_WR) + (size_t)l * NE * D;
#define R1_BAR() asm volatile("s_waitcnt lgkmcnt(0)\n\ts_barrier" ::: "memory")
    v2u xr[2][8], mw[2][8];
#define R1_ISSUE(itx) do { _Pragma("unroll") for (int rr = 0; rr < 2; ++rr) { const size_t o_ = (size_t)((itx) * 16 + 2 * wave + rr) * D + 4 * lane;                \
        _Pragma("unroll") for (int j = 0; j < 8; ++j) { xr[rr][j] = *(const v2u*)(xinb + o_ + 256 * j); \
            mw[rr][j] = *(const v2u*)(mix + o_ + 256 * j); } } } while (0)
    const int ipw = (T / 16 + G - 1) / G, itend = (bx + 1) * ipw < T / 16 ? (bx + 1) * ipw : T / 16;
    int nit = 0, it = bx * ipw;
    if (it < itend) R1_ISSUE(it);
    for (; it < itend; ++it, ++nit) {
#pragma unroll
        for (int rr = 0; rr < 2; ++rr) {
            const int r = 2 * wave + rr, t = it * 16 + r;
            const float* mb = modl + (size_t)(t / S) * NMOD;
            f32x4 v[8];
#pragma unroll
            for (int j = 0; j < 8; ++j) v[j] = (f32x4){bflo(xr[rr][j].x), bfhi(xr[rr][j].x), bflo(xr[rr][j].y), bfhi(xr[rr][j].y)};
            float ss = 0.f;
#pragma unroll
            for (int j = 0; j < 8; ++j) { const float y0 = bflo(mw[rr][j].x), y1 = bfhi(mw[rr][j].x), y2 = bflo(mw[rr][j].y), y3 = bfhi(mw[rr][j].y); ss += (y0 * y0 + y1 * y1) + (y2 * y2 + y3 * y3); }
            const float r1 = rsqrtf(wave_sum(ss) * (1.f / D) + EPS);
#pragma unroll
            for (int j = 0; j < 8; ++j) { const int c = 256 * j + 4 * lane;
                const f32x4 y = (f32x4){bflo(mw[rr][j].x), bfhi(mw[rr][j].x), bflo(mw[rr][j].y), bfhi(mw[rr][j].y)};
                v[j] += *(const f32x4*)(mb + 2 * D + c) * (y * r1);
                v2u o; o.x = pk2(v[j].x, v[j].y); o.y = pk2(v[j].z, v[j].w);
                *(v2u*)(xo + (size_t)t * D + c) = o; }
            float s2 = 0.f;
#pragma unroll
            for (int j = 0; j < 8; ++j) s2 += (v[j].x * v[j].x + v[j].y * v[j].y) + (v[j].z * v[j].z + v[j].w * v[j].w);
            const float r2 = rsqrtf(wave_sum(s2) * (1.f / D) + EPS);
#pragma unroll
            for (int j = 0; j < 8; ++j) { const int c = 256 * j + 4 * lane;
                const f32x4 h = v[j] * r2 * *(const f32x4*)(mb + 4 * D + c) + *(const f32x4*)(mb + 3 * D + c);
                v2u o; o.x = pk2(h.x, h.y); o.y = pk2(h.z, h.w);
                *(unsigned*)(hb8 + (size_t)t * D + c) = pk4_fp8(h.x, h.y, h.z, h.w); *(LAS v2u*)(H2T + r * 2056 + c) = o; }
        }
        if (it + 1 < itend) R1_ISSUE(it + 1);
        asm volatile("" ::: "memory");
        bf16x8 wf[8][2];
#pragma unroll
        for (int s = 0; s < 8; ++s)
#pragma unroll
            for (int hf = 0; hf < 2; ++hf) wf[s][hf] = *(const bf16x8*)(Wr + (size_t)(hf * 16 + (lane & 15)) * D + 256 * wave + 32 * s + 8 * (lane >> 4));
        R1_BAR();
        f32x4 acc0 = (f32x4){0.f, 0.f, 0.f, 0.f}, acc1 = (f32x4){0.f, 0.f, 0.f, 0.f};
#pragma unroll
        for (int s = 0; s < 8; ++s) { const bf16x8 af = *(const LAS bf16x8*)(H2T + (lane & 15) * 2056 + 256 * wave + 32 * s + 8 * (lane >> 4));
            acc0 = __builtin_amdgcn_mfma_f32_16x16x32_bf16(af, wf[s][0], acc0, 0, 0, 0); acc1 = __builtin_amdgcn_mfma_f32_16x16x32_bf16(af, wf[s][1], acc1, 0, 0, 0); }
#pragma unroll
        for (int i = 0; i < 4; ++i) { PART[(wave * 16 + 4 * (lane >> 4) + i) * 32 + (lane & 15)] = acc0[i]; PART[(wave * 16 + 4 * (lane >> 4) + i) * 32 + 16 + (lane & 15)] = acc1[i]; }
        R1_BAR();
        { const int row = tid >> 5, e = tid & 31; float sacc = a.in[I_RB][l * NE + e];
#pragma unroll
          for (int w = 0; w < 8; ++w) sacc += PART[(w * 16 + row) * 32 + e];
          LOGIT[row * 32 + e] = sacc; }
        R1_BAR();
        if (tid < 16) { int ix[4]; float gt[4]; top4_rows(LOGIT, tid, ix, gt); const int t = it * 16 + tid;
            *(int4*)(topi + t * 4) = make_int4(ix[0], ix[1], ix[2], ix[3]); *(float4*)(topg + t * 4) = make_float4(gt[0], gt[1], gt[2], gt[3]);
            *(LAS v4u*)(TOPI_L + (nit * 16 + tid) * 4) = (v4u){(unsigned)ix[0], (unsigned)ix[1], (unsigned)ix[2], (unsigned)ix[3]}; }
        R1_BAR();
    }
#undef R1_ISSUE
#undef R1_BAR
    if (tid < 32) LHIST[tid] = 0;
    __syncthreads();
    const int nasg = nit * 64;
    for (int q = tid; q < nasg; q += NWAVES * 64) LR_L[q] = __hip_atomic_fetch_add(LHIST + TOPI_L[q], 1, __ATOMIC_RELAXED, __HIP_MEMORY_SCOPE_WORKGROUP);
    __syncthreads();
    if (tid < 32) { const int n = LHIST[tid]; LBASE[tid] = n ? __hip_atomic_fetch_add(counts + tid, n, __ATOMIC_RELAXED, __HIP_MEMORY_SCOPE_AGENT) : 0; }
    __syncthreads();
    for (int q = tid; q < nasg; q += NWAVES * 64) { const int e = TOPI_L[q], rank = LBASE[e] + LR_L[q], t = (bx * ipw + (q >> 6)) * 16 + ((q >> 2) & 15);
        toprank[t * 4 + (q & 3)] = rank; rowtok[(size_t)e * T + rank] = t; }
}
template <bool LAST>
__device__ __forceinline__ void row2_phase(const Args& a, LAS unsigned char* lds, int l, int gw, int NGW) {
    int tid_l = threadIdx.x; asm volatile("" : "+v"(tid_l));
    const int tid = tid_l, lane = tid & 63;
    unsigned char* ws = a.ws;
    LAS int* SEG = (LAS int*)(lds + LX_TSTART);
    const int* counts = (const int*)(ws + WS_CTL) + CW_COUNTS + l * 32;
    __syncthreads();
    if (tid == 0) { int s = 0; for (int e = 0; e < NE; ++e) { SEG[e] = s; s += (counts[e] + 255) & ~255; } }
    __syncthreads();
    const int* topi = (const int*)(ws + WS_ROUT); const float* topg = (const float*)(ws + WS_ROUT + 256 * 1024); const int* toprank = (const int*)(ws + WS_ROUT + 512 * 1024);
    const unsigned char* ys = ws + WS_YS; unsigned char* hb = ws + WS_HB;
    const bf16* xinb = (const bf16*)(ws + WS_XB); bf16* xob = (bf16*)(ws + WS_XB); float* xo32 = a.out;
    const float* modl = (const float*)(ws + WS_MOD) + (size_t)l * 8 * NMOD;
    const int rpw = (T + NGW - 1) / NGW;
    const int t_first = (gw - (tid >> 6)) * rpw, bA = (t_first < T ? t_first : T - 1) / S;
    LAS float* prm = (LAS float*)lds;
    for (int i = tid * 4; i < 2 * 3 * D; i += NWAVES * 64 * 4) { const int bb = i / (3 * D), r_ = i - bb * 3 * D, k3 = r_ / D, c = r_ - k3 * D; int b = bA + bb; b = b < NB ? b : NB - 1;
        const float* src = (k3 == 0) ? modl + (size_t)b * NMOD + 5 * D : modl + (size_t)8 * NMOD + (size_t)b * NMOD + (k3 == 1 ? D : 0);
        *(LAS f32x4*)(prm + i) = (LAST && k3) ? (f32x4){0.f, 0.f, 0.f, 0.f} : *(const f32x4*)(src + c); }
    __syncthreads();
    for (int t0 = gw * rpw; t0 < (gw + 1) * rpw && t0 < T; t0 += 2) {
        int4 ei[2], rk[2]; float4 gg[2]; bool ok[2];
#pragma unroll
        for (int q = 0; q < 2; ++q) { const int t = t0 + q; ok[q] = t < T && t < (gw + 1) * rpw; const int tt = ok[q] ? t : t0;
            ei[q] = *(const int4*)(topi + tt * 4); rk[q] = *(const int4*)(toprank + tt * 4); gg[q] = *(const float4*)(topg + tt * 4); }
        unsigned yw[2][4][8]; v2u xw[2][8];
#pragma unroll
        for (int q = 0; q < 2; ++q) { const int tt = ok[q] ? t0 + q : t0;
            const unsigned char* y0 = ys + (size_t)(SEG[ei[q].x] + rk[q].x) * D + 4 * lane; const unsigned char* y1 = ys + (size_t)(SEG[ei[q].y] + rk[q].y) * D + 4 * lane;
            const unsigned char* y2 = ys + (size_t)(SEG[ei[q].z] + rk[q].z) * D + 4 * lane; const unsigned char* y3 = ys + (size_t)(SEG[ei[q].w] + rk[q].w) * D + 4 * lane;
#pragma unroll
            for (int j = 0; j < 8; ++j) { yw[q][0][j] = *(const unsigned*)(y0 + 256 * j); yw[q][1][j] = *(const unsigned*)(y1 + 256 * j); yw[q][2][j] = *(const unsigned*)(y2 + 256 * j); yw[q][3][j] = *(const unsigned*)(y3 + 256 * j);
                xw[q][j] = *(const v2u*)(xinb + (size_t)tt * D + 256 * j + 4 * lane); } }
#pragma unroll
        for (int q = 0; q < 2; ++q) if (ok[q]) { const int t = t0 + q;
            f32x4 y[8]; float ss = 0.f;
#pragma unroll
            for (int j = 0; j < 8; ++j) { f32x4 acc = unpk4_fp8(yw[q][0][j]) * gg[q].x; acc += unpk4_fp8(yw[q][1][j]) * gg[q].y; acc += unpk4_fp8(yw[q][2][j]) * gg[q].z; acc += unpk4_fp8(yw[q][3][j]) * gg[q].w;
                y[j] = acc; ss += (acc.x * acc.x + acc.y * acc.y) + (acc.z * acc.z + acc.w * acc.w); }
            const float r1 = rsqrtf(wave_sum(ss) * (1.f / D) + EPS);
            const LAS float* mb = prm + (t / S - bA) * 3 * D;
            f32x4 v[8];
#pragma unroll
            for (int j = 0; j < 8; ++j) { const int c = 256 * j + 4 * lane;
                v[j] = (f32x4){bflo(xw[q][j].x), bfhi(xw[q][j].x), bflo(xw[q][j].y), bfhi(xw[q][j].y)} + *(const LAS f32x4*)(mb + c) * (y[j] * r1);
                if constexpr (LAST) *(f32x4*)(xo32 + (size_t)t * D + c) = v[j];
                else { v2u o; o.x = pk2(v[j].x, v[j].y); o.y = pk2(v[j].z, v[j].w); *(v2u*)(xob + (size_t)t * D + c) = o; } }
            if constexpr (!LAST) prenorm_store_lds(v, mb + D, mb + 2 * D, hb + (size_t)t * D, lane);
        }
    }
}
__device__ __forceinline__ void unpk8(const v4u q, float (&z)[8]) { z[0] = bflo(q.x); z[1] = bfhi(q.x); z[2] = bflo(q.y); z[3] = bfhi(q.y); z[4] = bflo(q.z); z[5] = bfhi(q.z); z[6] = bflo(q.w); z[7] = bfhi(q.w); }
template <int W>
__device__ __forceinline__ void pool_item(const bf16* __restrict__ pcg, unsigned char* __restrict__ mixcat, int t0, int ch0) {
    const int s0 = t0 & (S - 1);
    v4u raw[W - 1 + 16];
#pragma unroll
    for (int i = 0; i < W - 1 + 16; ++i) { const bool valid = (s0 != 0) || (i >= W - 1); const int row = valid ? t0 - (W - 1) + i : t0;
        const v4u q = *(const v4u*)(pcg + (size_t)row * 2048 + ch0); raw[i] = valid ? q : (v4u){0u, 0u, 0u, 0u}; }
    float sum[8];
#pragma unroll
    for (int k = 0; k < 8; ++k) sum[k] = 0.f;
#pragma unroll
    for (int i = 0; i < W - 1; ++i) { float z[8]; unpk8(raw[i], z);
#pragma unroll
        for (int k = 0; k < 8; ++k) sum[k] += z[k]; }
#pragma unroll
    for (int i = 0; i < 16; ++i) { float z[8]; unpk8(raw[W - 1 + i], z);
#pragma unroll
        for (int k = 0; k < 8; ++k) sum[k] += z[k];
        const int cnt = (s0 + i + 1 < W) ? s0 + i + 1 : W; const float inv = 1.f / (float)cnt;
        v2u o; o.x = pk4_fp8(sum[0] * inv - z[0], sum[1] * inv - z[1], sum[2] * inv - z[2], sum[3] * inv - z[3]);
        o.y = pk4_fp8(sum[4] * inv - z[4], sum[5] * inv - z[5], sum[6] * inv - z[6], sum[7] * inv - z[7]);
        *(v2u*)(mixcat + (size_t)(t0 + i) * D + 1024 + ch0) = o;
        float zo[8]; unpk8(raw[i], zo);
#pragma unroll
        for (int k = 0; k < 8; ++k) sum[k] -= zo[k]; }
}
__device__ __forceinline__ void conv_item(const bf16* __restrict__ pcg, const float* __restrict__ cw, unsigned char* __restrict__ mixcat, int t0, int ch0) {
    const int s0 = t0 & (S - 1);
    v4u cr[10], hr[10], br[8];
#pragma unroll
    for (int i = 0; i < 10; ++i) { const bool valid = (s0 != 0) || (i >= 2); const int row = valid ? t0 - 2 + i : t0;
        const v4u c4 = *(const v4u*)(pcg + (size_t)row * 2048 + 1024 + ch0), h4 = *(const v4u*)(pcg + (size_t)row * 2048 + 1536 + ch0);
        cr[i] = valid ? c4 : (v4u){0u, 0u, 0u, 0u}; hr[i] = valid ? h4 : (v4u){0u, 0u, 0u, 0u}; }
#pragma unroll
    for (int i = 0; i < 8; ++i) br[i] = *(const v4u*)(pcg + (size_t)(t0 + i) * 2048 + 512 + ch0);
    float w0[8], w1[8], w2[8];
#pragma unroll
    for (int k = 0; k < 8; ++k) { w0[k] = cw[ch0 + k]; w1[k] = cw[512 + ch0 + k]; w2[k] = cw[1024 + ch0 + k]; }
    float ua[8], ub[8];
    { float c[8], h[8]; unpk8(cr[0], c); unpk8(hr[0], h);
#pragma unroll
      for (int k = 0; k < 8; ++k) ua[k] = c[k] * h[k];
      unpk8(cr[1], c); unpk8(hr[1], h);
#pragma unroll
      for (int k = 0; k < 8; ++k) ub[k] = c[k] * h[k]; }
#pragma unroll
    for (int i = 0; i < 8; ++i) { float c[8], h[8], b[8], o[8]; unpk8(cr[i + 2], c); unpk8(hr[i + 2], h); unpk8(br[i], b);
#pragma unroll
        for (int k = 0; k < 8; ++k) { const float uc = c[k] * h[k]; o[k] = b[k] * (w0[k] * ua[k] + w1[k] * ub[k] + w2[k] * uc); ua[k] = ub[k]; ub[k] = uc; }
        v2u w; w.x = pk4_fp8(o[0], o[1], o[2], o[3]); w.y = pk4_fp8(o[4], o[5], o[6], o[7]);
        *(v2u*)(mixcat + (size_t)(t0 + i) * D + 1536 + ch0) = w; }
}
__device__ __forceinline__ void poolconv_phase(const Args& a, int l, int gw, int NGW) {
    int lane_l = threadIdx.x & 63; asm volatile("" : "+v"(lane_l));
    const int lane = lane_l;
    const bf16* pcg = (const bf16*)(a.ws + WS_PCG); unsigned char* mixcat = a.ws + WS_MIXCAT;
    const float* cw = a.in[I_CONVW] + (size_t)l * 3 * 512;
    for (int it = gw; it < T / 8 + (T / 64) * 4; it += NGW) {
        if (it < T / 8) conv_item(pcg, cw, mixcat, it * 8, lane * 8);
        else { const int r = it - T / 8, g = r & 3, t0 = (r >> 2) * 64 + (lane >> 4) * 16, ch0 = g * 128 + (lane & 15) * 8;
            if (g == 0) pool_item<2>(pcg, mixcat, t0, ch0); else if (g == 1) pool_item<4>(pcg, mixcat, t0, ch0); else if (g == 2) pool_item<8>(pcg, mixcat, t0, ch0); else pool_item<16>(pcg, mixcat, t0, ch0); }
    }
}

namespace att {
typedef float f32x16 __attribute__((ext_vector_type(16)));
typedef short s16x4 __attribute__((ext_vector_type(4)));
typedef const LAS char* lcp;
constexpr int NW = 8, QBLK = 32, KVBLK = 64, QB = 256, HD = 128;
constexpr int SHM_V = KVBLK * HD * 2, SHM_K = KVBLK * HD * 2;
constexpr int L_WS = 2 * SHM_V + 2 * SHM_K;
constexpr int L_KM = L_WS + NW * 64 * 4;
constexpr int L_LUT = L_KM + 4096;
constexpr int NQT = 216;
constexpr int LDS_ATT = L_LUT + NQT * 16;
static_assert(LDS_ATT <= RING_BYTES, "attention LDS");
constexpr float SCALE = 0.08838834764831845f, THR = 8.f;
constexpr int LDO = 2048;
#define KSWZ(row, colB) ((row) * 256 + ((colB) ^ (((row) & 7) << 4)))
#define SBAR() __builtin_amdgcn_sched_barrier(0)
__device__ __forceinline__ int v_st(int k, int c) { const int kk = (k & ~0xC) | ((k & 4) << 1) | ((k & 8) >> 1); return ((kk >> 3) * 4 + (c >> 5)) * 512 + ((kk & 7) * 32 + (c & 31)) * 2; }
__device__ __forceinline__ int v_rd_base(int lane) { return ((lane & 3) << 3) | (((lane >> 2) & 3) << 6) | (((lane >> 4) & 1) << 5) | (((lane >> 5) & 1) << 8); }
constexpr int v_rd_off(int d0, int ks, int half) { return d0 * 512 + ks * 4096 + half * 2048; }
__device__ __forceinline__ int crow(int r, int hi) { return (r & 3) + 8 * (r >> 2) + 4 * hi; }
__device__ __forceinline__ unsigned cvtpk(float lo, float hi) { unsigned r; asm volatile("v_cvt_pk_bf16_f32 %0, %1, %2" : "=v"(r) : "v"(lo), "v"(hi)); return r; }
__device__ __forceinline__ bf16x8 load8(const bf16* p) { return *reinterpret_cast<const bf16x8*>(p); }
__device__ __forceinline__ void partialSM(f32x16& p0, f32x16& p1, float& m_reg, float& mn, float& alpha) {
    float pmax = p0[0]; for (int r = 1; r < 16; ++r) pmax = fmaxf(pmax, p0[r]); for (int r = 0; r < 16; ++r) pmax = fmaxf(pmax, p1[r]);
    { auto rr = __builtin_amdgcn_permlane32_swap(__float_as_uint(pmax), __float_as_uint(pmax), false, false);
      pmax = fmaxf(__uint_as_float(rr[0]), __uint_as_float(rr[1])); }
    constexpr float C2 = 1.4426950408889634f * SCALE;
    if (__builtin_expect(__all((pmax - m_reg) * SCALE <= THR), 1)) { mn = m_reg; alpha = 1.f; }
    else { mn = fmaxf(m_reg, pmax); alpha = __builtin_amdgcn_exp2f((m_reg - mn) * C2); m_reg = mn; }
    const float mnL = -mn * C2;
    for (int r = 0; r < 16; ++r) p0[r] = fmaf(p0[r], C2, mnL); for (int r = 0; r < 16; ++r) p1[r] = fmaf(p1[r], C2, mnL);
    for (int r = 0; r < 16; ++r) p0[r] = __builtin_amdgcn_exp2f(p0[r]);
}
__device__ __forceinline__ void finishSM(f32x16& p0, f32x16& p1, float alpha, float& l_reg, bf16x8& pa0, bf16x8& pa1, bf16x8& pa2, bf16x8& pa3) {
    for (int r = 0; r < 16; ++r) p1[r] = __builtin_amdgcn_exp2f(p1[r]);
    float ps = 0; for (int r = 0; r < 16; ++r) ps += p0[r]; for (int r = 0; r < 16; ++r) ps += p1[r];
    { auto rr = __builtin_amdgcn_permlane32_swap(__float_as_uint(ps), __float_as_uint(ps), false, false);
      ps = __uint_as_float(rr[0]) + __uint_as_float(rr[1]); }
    l_reg = l_reg * alpha + ps;
#define PK4(P, B_, OUT) do { unsigned a0 = cvtpk(P[B_+0], P[B_+1]), a1 = cvtpk(P[B_+2], P[B_+3]);                          \
        unsigned b0 = cvtpk(P[B_+4], P[B_+5]), b1 = cvtpk(P[B_+6], P[B_+7]);                                             \
        auto r0 = __builtin_amdgcn_permlane32_swap(a0, b0, false, false); auto r1 = __builtin_amdgcn_permlane32_swap(a1, b1, false, false); \
        v4u w = {r0[0], r1[0], r0[1], r1[1]}; OUT = *reinterpret_cast<bf16x8*>(&w); } while (0)
    PK4(p0, 0, pa0); PK4(p0, 8, pa1); PK4(p1, 0, pa2); PK4(p1, 8, pa3);
#undef PK4
}
template <int KB>
__device__ __forceinline__ void qkt(f32x16& p0, f32x16& p1, lcp K_lds, int r32, int hi, const bf16x8* qr, float init) {
#pragma unroll
    for (int r = 0; r < 16; ++r) { p0[r] = init; p1[r] = init; }
    lcp kb[4];
#pragma unroll
    for (int dd = 0; dd < 4; ++dd) kb[dd] = K_lds + KB * SHM_K + KSWZ(r32, (dd * 16 + hi * 8) * 2);
#pragma unroll
    for (int d0 = 0; d0 < 8; ++d0) { lcp a = kb[d0 & 3] + (d0 >> 2) * 128;
        bf16x8 b0 = *reinterpret_cast<const LAS bf16x8*>(a);
        bf16x8 b1 = *reinterpret_cast<const LAS bf16x8*>(a + 32 * 256);
        p0 = __builtin_amdgcn_mfma_f32_32x32x16_bf16(b0, qr[d0], p0, 0, 0, 0);
        p1 = __builtin_amdgcn_mfma_f32_32x32x16_bf16(b1, qr[d0], p1, 0, 0, 0); }
}
template <int VB>
__device__ __forceinline__ void pv_tile(f32x16* o, int vb0, bf16x8 pa0, bf16x8 pa1, bf16x8 pa2, bf16x8 pa3) {
#define TRRD(dst, off) asm volatile("ds_read_b64_tr_b16 %0, %1 offset:%2" : "=&v"(dst) : "v"(vb0), "i"(off) : "memory")
#define PV_RD(L, Hh, ks) do { constexpr int b_ = VB * SHM_V + v_rd_off(0, ks, 0); TRRD(L[0], b_); TRRD(Hh[0], b_ + 2048); TRRD(L[1], b_ + 512); TRRD(Hh[1], b_ + 512 + 2048); \
        TRRD(L[2], b_ + 1024); TRRD(Hh[2], b_ + 1024 + 2048); TRRD(L[3], b_ + 1536); TRRD(Hh[3], b_ + 1536 + 2048); } while (0)
#define PV_MM(L, Hh, pa) do { _Pragma("unroll") for (int d0 = 0; d0 < 4; ++d0) \
        o[d0] = __builtin_amdgcn_mfma_f32_32x32x16_bf16(pa, (bf16x8){L[d0][0], L[d0][1], L[d0][2], L[d0][3], Hh[d0][0], Hh[d0][1], Hh[d0][2], Hh[d0][3]}, o[d0], 0, 0, 0); } while (0)
    s16x4 la[4], ha[4], lb[4], hb[4];
    PV_RD(la, ha, 0); PV_RD(lb, hb, 1);
    asm volatile("s_waitcnt lgkmcnt(8)" ::: "memory"); SBAR(); PV_MM(la, ha, pa0); SBAR();
    PV_RD(la, ha, 2);
    asm volatile("s_waitcnt lgkmcnt(8)" ::: "memory"); SBAR(); PV_MM(lb, hb, pa1); SBAR();
    PV_RD(lb, hb, 3);
    asm volatile("s_waitcnt lgkmcnt(8)" ::: "memory"); SBAR(); PV_MM(la, ha, pa2); SBAR();
    asm volatile("s_waitcnt lgkmcnt(0)" ::: "memory"); SBAR(); PV_MM(lb, hb, pa3);
#undef PV_RD
#undef PV_MM
#undef TRRD
}
__device__ __forceinline__ void bias_mask_tile(f32x16& p0, f32x16& p1, int dq, lcp qt, bool diag) {
#pragma unroll
    for (int j = 0; j < 4; ++j) {
        int i0 = dq - 8 * j, i1 = i0 - 32;
        i0 = i0 < 0 ? 0 : (i0 > NQT - 1 ? NQT - 1 : i0); i1 = i1 < 0 ? 0 : (i1 > NQT - 1 ? NQT - 1 : i1);
        const f32x4 q0 = *(const LAS f32x4*)(qt + i0 * 16), q1 = *(const LAS f32x4*)(qt + i1 * 16);
        p0[4 * j + 0] += q0[3]; p0[4 * j + 1] += q0[2]; p0[4 * j + 2] += q0[1]; p0[4 * j + 3] += q0[0];
        p1[4 * j + 0] += q1[3]; p1[4 * j + 1] += q1[2]; p1[4 * j + 2] += q1[1]; p1[4 * j + 3] += q1[0];
    }
    if (diag) {
        const float NEG = -__builtin_inff();
#pragma unroll
        for (int r = 0; r < 16; ++r) { const int c = (r & 3) + 8 * (r >> 2); if (dq - c < 0) p0[r] = NEG; if (dq - c - 32 < 0) p1[r] = NEG; }
    }
}
struct HeadRef { const bf16* Q; const bf16* K; const bf16* V; unsigned char* O; };
struct Seam { bf16x8 qr[8]; bf16x8 st_v0, st_v1, st_k0, st_k1; };
#define ROW(p, k0, rr) ((p) + (unsigned)(((k0) + (rr)) * HD + sc))
#define VMW() asm volatile("s_waitcnt vmcnt(0)" ::: "memory")
#define VMWN(n) asm volatile("s_waitcnt vmcnt(%0)" :: "i"(n) : "memory")
#define SLOAD_H(Kp, Vp, k0) do { S.st_v0 = load8(ROW(Vp, k0, sr)); S.st_v1 = load8(ROW(Vp, k0, 32 + sr));              \
                         S.st_k0 = load8(ROW(Kp, k0, sr)); S.st_k1 = load8(ROW(Kp, k0, 32 + sr)); } while (0)
#define SWRITE_HK(bf) do { *(LAS bf16x8*)(K_lds + (bf) * SHM_K + kws) = S.st_k0; *(LAS bf16x8*)(K_lds + (bf) * SHM_K + kws + 32 * 256) = S.st_k1; } while (0)
#define SWRITE_HV(bf) do { *(LAS bf16x8*)(V_lds + (bf) * SHM_V + vst0) = S.st_v0; *(LAS bf16x8*)(V_lds + (bf) * SHM_V + vst1) = S.st_v1; } while (0)
#define SWRITE_H(bf) do { SWRITE_HV(bf); SWRITE_HK(bf); } while (0)
__device__ __forceinline__ void stage_head(LAS char* lds, const float* __restrict__ kmsum, const float* __restrict__ relb, int h, int tid) {
    { LAS bf16* kmh = (LAS bf16*)(lds + L_KM); LAS bf16* kml = kmh + 1024;
      for (int i = tid; i < 1024; i += 512) { const float v = kmsum[i]; const unsigned hb_ = f2bf(v); kmh[i] = (bf16)hb_; kml[i] = (bf16)f2bf(v - bf2f(hb_)); } }
    if (tid < NQT) {
#pragma unroll
        for (int k = 0; k < 4; ++k) { int n = tid - 3 + k; n = n < 0 ? 0 : (n > 113 ? 113 : n); int bkt = n;
            if (n >= 16) { bkt = 16; bkt += (n >= 19); bkt += (n >= 21); bkt += (n >= 24); bkt += (n >= 27); bkt += (n >= 31); bkt += (n >= 35); bkt += (n >= 40); bkt += (n >= 46);
                bkt += (n >= 52); bkt += (n >= 59); bkt += (n >= 67); bkt += (n >= 77); bkt += (n >= 87); bkt += (n >= 99); bkt += (n >= 113); }
            ((LAS float*)(lds + L_LUT))[tid * 4 + k] = relb[bkt * 8 + h] * (1.0f / SCALE); } }
}
__device__ __forceinline__ void moba_block(const HeadRef& H, int qb, LAS char* lds, int tid) {
    const int wid = __builtin_amdgcn_readfirstlane(tid >> 6), lane = tid & 63, r32 = lane & 31, hi = lane >> 5;
    const int NT = 4 * (qb + 1);
    const int qlo = qb * QB + wid * QBLK, qm = qlo + r32 - 4 * hi;
    LAS char* V_lds = lds; LAS char* K_lds = lds + 2 * SHM_V;
    LAS float* ws = (LAS float*)(lds + L_WS) + wid * 64; LAS float* li_l = ws; LAS float* al_l = ws + 32;
    lcp lut = lds + L_LUT;
    unsigned kofs[2], vofs[2];
#pragma unroll
    for (int g2 = 0; g2 < 2; ++g2) { const int p = (wid + 8 * g2) * 64 + lane;
        { const int r = p >> 4, cc = (p & 15) ^ (r & 7); kofs[g2] = (unsigned)(r * HD + cc * 8); }
        { const int st = p >> 5, kk = (st >> 2) * 8 + ((p >> 2) & 7), k = (kk & ~0xC) | ((kk & 4) << 1) | ((kk & 8) >> 1), c = (st & 3) * 32 + (p & 3) * 8; vofs[g2] = (unsigned)(k * HD + c); } }
    const int vb0 = (int)(uintptr_t)V_lds + v_rd_base(lane);
    const bf16* Kh = H.K; const bf16* Vh = H.V;
    Seam S;
    { const bf16* curQ = H.Q + (unsigned)(qb * QB * HD);
#pragma unroll
      for (int d0 = 0; d0 < 8; ++d0) S.qr[d0] = load8(curQ + (unsigned)((wid * QBLK + r32) * HD + d0 * 16 + hi * 8)); }
#define DMA_TILE(t1, BUF1) do { _Pragma("unroll") for (int g2 = 0; g2 < 2; ++g2) {                                                                                      \
        __builtin_amdgcn_global_load_lds((const unsigned*)(Kh + (unsigned)(KBASE(t1) * HD) + kofs[g2]), (LAS unsigned*)(K_lds + (BUF1) * SHM_K + (wid + 8 * g2) * 1024), 16, 0, 0); \
        __builtin_amdgcn_global_load_lds((const unsigned*)(Vh + (unsigned)(KBASE(t1) * HD) + vofs[g2]), (LAS unsigned*)(V_lds + (BUF1) * SHM_V + (wid + 8 * g2) * 1024), 16, 0, 0); } } while (0)
#define KBASE(t) ((t) * KVBLK)
    DMA_TILE(0, 0);
    VMW();
    __syncthreads();
    unsigned selmask = 0u;
    if (qb > 0) {
        f32x16 gs;
#pragma unroll
        for (int r = 0; r < 16; ++r) gs[r] = 0.f;
        lcp kmh = lds + L_KM + (r32 & 7) * 256 + hi * 16;
#pragma unroll
        for (int d0 = 0; d0 < 8; ++d0) { const bf16x8 ah = *reinterpret_cast<const LAS bf16x8*>(kmh + d0 * 32), al = *reinterpret_cast<const LAS bf16x8*>(kmh + 2048 + d0 * 32);
            gs = __builtin_amdgcn_mfma_f32_32x32x16_bf16(ah, S.qr[d0], gs, 0, 0, 0); gs = __builtin_amdgcn_mfma_f32_32x32x16_bf16(al, S.qr[d0], gs, 0, 0, 0); }
        float g[8];
#pragma unroll
        for (int r = 0; r < 4; ++r) { const float mine = gs[r], oth = __shfl_xor(mine, 32); g[r] = hi ? oth : mine; g[4 + r] = hi ? mine : oth; }
#pragma unroll
        for (int pass = 0; pass < 3; ++pass) { int best = -1; float bv = -__builtin_inff();
#pragma unroll
            for (int n = 0; n < 7; ++n) { const bool take = (n < qb) && !((selmask >> n) & 1u) && g[n] > bv; bv = take ? g[n] : bv; best = take ? n : best; }
            if (best >= 0) selmask |= 1u << best; }
    }
    const float cfar = __builtin_bit_cast(float, __builtin_amdgcn_readfirstlane(__builtin_bit_cast(int, *(const LAS float*)(lut + (113 + 3) * 16))));
    float m_reg = -1e30f, l_reg = 0; f32x16 o[4] = {};
#define FAR(t) (qlo - (KBASE(t) + KVBLK - 1) >= 113)
#define INITV(t) (((((t) >> 2) == qb) || ((selmask >> ((t) >> 2)) & 1u)) ? (FAR(t) ? cfar : 0.f) : -__builtin_inff())
#define MASKT(P0_, P1_, t) do { if (!FAR(t)) bias_mask_tile(P0_, P1_, qm - KBASE(t), lut, KBASE(t) + KVBLK - 1 > qlo); } while (0)
#define RESC(a) do { if (__any((a) < 1.f)) { if (hi == 0) al_l[r32] = (a); asm volatile("s_waitcnt lgkmcnt(0)" ::: "memory");              \
                     for (int d_ = 0; d_ < 4; ++d_) for (int r = 0; r < 16; ++r) o[d_][r] *= al_l[crow(r, hi)]; } } while (0)
    f32x16 p0, p1; float mn, al; bf16x8 pa0, pa1, pa2, pa3;
#define TILE_STEP(t, BUF) do {                                                                                               \
        if ((t) + 1 < NT) DMA_TILE((t) + 1, 1 - BUF);     \
        if (KBASE(t) <= qlo + QBLK - 1) {     \
        SBAR(); qkt<BUF>(p0, p1, K_lds, r32, hi, S.qr, INITV(t));                                                            \
        MASKT(p0, p1, (t)); partialSM(p0, p1, m_reg, mn, al); RESC(al); finishSM(p0, p1, al, l_reg, pa0, pa1, pa2, pa3); SBAR(); \
        pv_tile<BUF>(o, vb0, pa0, pa1, pa2, pa3); }                                                                           \
        VMW();                                                                                                                \
        __syncthreads(); } while (0)
    if (wid < 4) __builtin_amdgcn_s_setprio(2); else __builtin_amdgcn_s_setprio(0);
    for (int t = 0; t < NT; t += 2) { TILE_STEP(t, 0); TILE_STEP(t + 1, 1); }
    __builtin_amdgcn_s_setprio(0);
    if (hi == 0) li_l[r32] = l_reg; asm volatile("s_waitcnt lgkmcnt(0)" ::: "memory");
    float rli[16];
#pragma unroll
    for (int r = 0; r < 16; ++r) rli[r] = __builtin_amdgcn_rcpf(li_l[crow(r, hi)]);
    unsigned char* Ow = H.O + (unsigned)((qb * QB + wid * QBLK) * LDO);
    LAS unsigned char* ot = (LAS unsigned char*)K_lds + wid * 4096;
#pragma unroll
    for (int r = 0; r < 16; ++r) { const int orow = crow(r, hi);
#pragma unroll
        for (int d0 = 0; d0 < 4; ++d0) ot[orow * 128 + d0 * 32 + r32] = (unsigned char)(__builtin_amdgcn_cvt_pk_fp8_f32(clamp448(o[d0][r] * rli[r]), 0.f, 0, false) & 0xffu); }
    asm volatile("s_waitcnt lgkmcnt(0)" ::: "memory");
#pragma unroll
    for (int it = 0; it < 4; ++it) { const int row = it * 8 + (lane >> 3), ch = lane & 7;
        *(v4u*)(Ow + (unsigned)(row * LDO + ch * 16)) = *(const LAS v4u*)(ot + row * 128 + ch * 16); }
    __syncthreads();
#undef RESC
#undef KBASE
#undef FAR
#undef INITV
#undef MASKT
#undef TILE_STEP
#undef DMA_TILE
}
#undef ROW
#undef VMW
#undef VMWN
#undef SLOAD_H
#undef SWRITE_HK
#undef SWRITE_HV
#undef SWRITE_H
#undef KSWZ
#undef SBAR
}
__device__ __forceinline__ void attn_phase(const Args& a, LAS unsigned char* lds_u, int l, int G, int vcu) {
    int tid_l = threadIdx.x; asm volatile("" : "+v"(tid_l));
    const int tid = tid_l;
    LAS char* lds = (LAS char*)lds_u;
    const bf16* Qb = (const bf16*)(a.ws + WS_Q); const bf16* Kb = (const bf16*)(a.ws + WS_K); const bf16* Vb = (const bf16*)(a.ws + WS_V); unsigned char* mixcat = a.ws + WS_MIXCAT;
    const float* kmsum = (const float*)(a.ws + WS_KMEAN) + (size_t)l * 8 * 8 * 8 * 128;
    for (int L = vcu; L < 256; L += G) {
        const int bh = L >> 2, y = L & 3, b = bh >> 3, h = bh & 7;
        const size_t hbase = (size_t)bh * S * 128;
        att::HeadRef H; H.Q = Qb + hbase; H.K = Kb + hbase; H.V = Vb + hbase; H.O = mixcat + (size_t)b * S * D + h * 128;
        __syncthreads();
        att::stage_head(lds, kmsum + (size_t)bh * 8 * 128, a.in[I_RELB], h, tid);
#pragma unroll 1
        for (int pass = 0; pass < 2; ++pass) att::moba_block(H, pass ? 7 - y : y, lds, tid);
    }
}

constexpr int NPHASE = 3 + 7 * NL;
__global__ void __launch_bounds__(NWAVES * 64, 2) mk_fwd(Args args) {
    extern __shared__ __attribute__((aligned(16))) unsigned char lds_raw[];
    LAS unsigned char* lds = (LAS unsigned char*)lds_raw;
    const int tid = threadIdx.x, lane = tid & 63, wave = __builtin_amdgcn_readfirstlane(tid >> 6);
    const int G = gridDim.x, bx = blockIdx.x, vcu = (G % 8 == 0) ? (bx % 8) * (G / 8) + bx / 8 : bx;
    const int gw = vcu * NWAVES + wave, NGW = G * NWAVES;
    volatile LAS unsigned* MISC = (volatile LAS unsigned*)(lds + LX_MISC);
    if (tid < 16) MISC[tid] = 0u;
    __syncthreads();
    unsigned* ctl = (unsigned*)(args.ws + WS_CTL);
    XcdBarrier bar = xcd_barrier_post(ctl + CW_BAR + args.li * XCD_BAR_WORDS, MISC);
    const int lo = args.ph_lo, hi = args.ph_hi;
#define IN(k) (lo <= (k) && (k) < hi)
#define SEAM(k) do { if (IN(k) && IN((k) + 1)) xcd_barrier(bar); } while (0)
    if (IN(0)) p0a(args, lds, gw, NGW, wave, lane, tid);
    SEAM(0);
    if (IN(1)) { p0b(args, gw, NGW, lane); p0c(args, lds, gw, NGW, lane, tid); }
    SEAM(1);
    for (int l = 0; l < NL; ++l) {
        const int pb = 3 + 7 * l;
        if (IN(pb + 0)) {
            pg8::DenseOrder So; So.init((const bf16*)(args.ws + WS_HB), (const bf16*)(args.ws + WS_WIN + (size_t)l * DIN * D), T, DIN, D / 2, G, bx);
            pg8::EpiInProj E{(bf16*)(args.ws + WS_Q), (WS_K - WS_Q) / 2, (bf16*)(args.ws + WS_PCG), (float*)(args.ws + WS_KMEAN) + (size_t)l * 8 * 8 * 8 * 128, 1.f / WSCALE};
            pg8::gemm_phase<pg8::EpiInProj, pg8::DenseOrder, true, true>(lds, D / 2, So, E);
        }
        SEAM(pb + 0);
        if (IN(pb + 1)) {
            const bool early = ((bx >> 3) & 1) == 0;
            if (early) { weight_transposes<3>(args, lds, gw, NGW, wave, lane, l, l == 0 ? 1 : -1); __syncthreads(); }
            attn_phase(args, lds, l, G, vcu); poolconv_phase(args, l, gw, NGW);
            if (!early) { __syncthreads(); weight_transposes<3>(args, lds, gw, NGW, wave, lane, l, l == 0 ? 1 : -1); }
        }
        SEAM(pb + 1);
        if (IN(pb + 2)) {
            pg8::DenseOrder So; So.init((const bf16*)(args.ws + WS_MIXCAT), (const bf16*)(args.ws + WS_WOUT + (size_t)l * D * D), T, D, D / 2, G, bx);
            pg8::EpiPlain E{(bf16*)(args.ws + WS_MIX), D, nullptr, 1.f / WSCALE};
            pg8::gemm_phase<pg8::EpiPlain, pg8::DenseOrder, true, true>(lds, D / 2, So, E);
        }
        SEAM(pb + 2);
        if (IN(pb + 3)) row1_phase(args, lds, l, G, bx);
        SEAM(pb + 3);
        if (IN(pb + 4)) {
            pg8::GroupedGather So; grouped_prepare(lds, (const int*)(ctl + CW_COUNTS + l * 32), (const int*)(args.ws + WS_ROWTOK), true, G, bx, So);
            So.A = (const char*)(args.ws + WS_HB8); So.Bt = (const char*)(args.ws + WS_WGU + (size_t)l * NE * 2048 * D); So.K = D / 2;
            pg8::EpiGU E{args.ws + WS_ACT, args.in[I_BG] + (size_t)l * NE * DE, args.in[I_BU] + (size_t)l * NE * DE, 1.f / WSCALE, (LAS float*)(lds + LX_BIAS)};
            pg8::gemm_phase<pg8::EpiGU, pg8::GroupedGather, true, true>(lds, D / 2, So, E);
        }
        SEAM(pb + 4);
        if (IN(pb + 5)) {
            pg8::GroupedDense So; grouped_prepare(lds, (const int*)(ctl + CW_COUNTS + l * 32), (const int*)(args.ws + WS_ROWTOK), false, G, bx, So);
            So.A = (const char*)(args.ws + WS_ACT); So.Bt = (const char*)(args.ws + WS_WDN + (size_t)l * NE * 2048 * DE); So.K = DE / 2;
            pg8::EpiPlain8 E{args.ws + WS_YS, args.in[I_BD] + (size_t)l * NE * D, 1.f / WSCALE, (LAS float*)(lds + LX_BIAS)};
            pg8::gemm_phase<pg8::EpiPlain8, pg8::GroupedDense, true, true>(lds, DE / 2, So, E);
        }
        SEAM(pb + 5);
        if (IN(pb + 6)) { if (l + 1 < NL) row2_phase<false>(args, lds, l, gw, NGW); else row2_phase<true>(args, lds, l, gw, NGW); }
        SEAM(pb + 6);
    }
#undef IN
#undef SEAM
}

static void launch_mk(const Args& base, int lo, int hi, int li, int grid, hipStream_t stream) {
    Args a = base; a.ph_lo = lo; a.ph_hi = hi; a.li = li; a.pad = 0;
    hipLaunchKernelGGL(mk_fwd, dim3(grid), dim3(NWAVES * 64), LDS_BYTES, stream, a);
}
extern "C" void kernel_launch(void* const* d_in, const int* in_sizes, int n_in, void* d_out, int out_size, void* d_ws, size_t ws_size, hipStream_t stream) {
    static int grid = 0;
    if (grid == 0) {
        if (n_in != 22 || out_size != T * D || ws_size < WS_END) { fprintf(stderr, "kernel_launch: unexpected shapes / workspace (%d inputs, out %d, ws %zu)\n", n_in, out_size, ws_size); grid = -1; return; }
        int dev = 0, cus = 0, per_cu = 0;
        (void)hipGetDevice(&dev); (void)hipDeviceGetAttribute(&cus, hipDeviceAttributeMultiprocessorCount, dev);
        (void)hipFuncSetAttribute((const void*)mk_fwd, hipFuncAttributeMaxDynamicSharedMemorySize, LDS_BYTES);
        (void)hipOccupancyMaxActiveBlocksPerMultiprocessor(&per_cu, (const void*)mk_fwd, NWAVES * 64, LDS_BYTES);
        if (per_cu < 1) fprintf(stderr, "kernel_launch: occupancy query says %d blocks per CU\n", per_cu);
        (void)hipGetLastError();
        grid = cus >= 64 ? (cus / 64) * 64 : 64;
    }
    if (grid < 0) return;
    unsigned char* ws = (unsigned char*)d_ws;
    (void)hipMemsetAsync(ws + WS_CTL, 0, CTL_ZERO_BYTES, stream);
    Args a{};
    for (int i = 0; i < 22; ++i) a.in[i] = (const float*)d_in[i];
    a.out = (float*)d_out; a.ws = ws;
    launch_mk(a, 0, NPHASE, 0, grid, stream);
}
```

```cpp
#include <hip/hip_runtime.h>
#include <cstdio>
#include <cstdint>

constexpr int D = 2048, NB = 8, S = 2048, T = NB * S, NL = 2;
constexpr int DIN = 5120, NH = 8;
constexpr int NE = 32, TK = 4, DE = 1024;
constexpr int NMOD = 6 * D;
constexpr float EPS = 1e-6f;
constexpr float ATT_SCALE = 0.08838834764831845f;
constexpr int PROWS = T * TK + NE * 256;

#define GAS __attribute__((address_space(1)))
#define LAS __attribute__((address_space(3)))
typedef unsigned short bf16;
typedef unsigned v4u __attribute__((ext_vector_type(4)));
typedef unsigned v2u __attribute__((ext_vector_type(2)));
typedef float f32x4 __attribute__((ext_vector_type(4)));
typedef short bf16x8 __attribute__((ext_vector_type(8)));
#define LDS_WAIT() asm volatile("s_waitcnt lgkmcnt(0)" ::: "memory")
#define VM_WAIT() asm volatile("s_waitcnt vmcnt(0)" ::: "memory")
__device__ __forceinline__ unsigned f2bf(float f) { unsigned u = __builtin_bit_cast(unsigned, f); return (u + 0x7fffu + ((u >> 16) & 1u)) >> 16; }
__device__ __forceinline__ unsigned pk2(float lo, float hi) { return f2bf(lo) | (f2bf(hi) << 16); }
__device__ __forceinline__ float bf2f(unsigned b) { return __builtin_bit_cast(float, b << 16); }
__device__ __forceinline__ float clamp448(float x) { return __builtin_fminf(__builtin_fmaxf(x, -448.f), 448.f); }
__device__ __forceinline__ unsigned pk4_fp8(float a, float b, float c, float d) {
    unsigned w = __builtin_amdgcn_cvt_pk_fp8_f32(clamp448(a), clamp448(b), 0, false);
    return __builtin_amdgcn_cvt_pk_fp8_f32(clamp448(c), clamp448(d), w, true);
}
typedef float f32x2_t __attribute__((ext_vector_type(2)));
__device__ __forceinline__ f32x4 unpk4_fp8(unsigned w) { const f32x2_t lo = __builtin_amdgcn_cvt_pk_f32_fp8(w, false), hi = __builtin_amdgcn_cvt_pk_f32_fp8(w, true); return (f32x4){lo.x, lo.y, hi.x, hi.y}; }
__device__ __forceinline__ float bflo(unsigned w) { return __builtin_bit_cast(float, w << 16); }
__device__ __forceinline__ float bfhi(unsigned w) { return __builtin_bit_cast(float, w & 0xffff0000u); }

constexpr size_t MiB = 1u << 20;
constexpr size_t WS_CTL = 0, CTL_ZERO_BYTES = 2 * MiB;
constexpr size_t WS_KMEAN = 1 * MiB;
constexpr size_t WS_MOD = 2 * MiB;
constexpr size_t WS_MODP = 3 * MiB;
constexpr size_t WS_ROUT = 16 * MiB;
constexpr size_t WS_ROWTOK = 17 * MiB;
constexpr size_t WS_WR = 19 * MiB;
constexpr size_t WS_WIN = 20 * MiB;
constexpr size_t WS_WOUT = 60 * MiB;
constexpr size_t WS_WGU = 76 * MiB;
constexpr size_t WS_WDN = 588 * MiB;
constexpr size_t WS_HB8 = 716 * MiB;
constexpr float WSCALE = 64.f;
constexpr size_t WS_HB = 844 * MiB;
constexpr size_t WS_ACT = 908 * MiB;
constexpr size_t WS_YS = 1052 * MiB;
constexpr size_t WS_Q = 1340 * MiB, WS_K = 1372 * MiB, WS_V = 1404 * MiB;
constexpr size_t WS_PCG = 1436 * MiB;
constexpr size_t WS_MIXCAT = 1500 * MiB;
constexpr size_t WS_MIX = 1564 * MiB;
constexpr size_t WS_XB = 1628 * MiB;
constexpr size_t WS_END = 1692 * MiB;
constexpr size_t WS_GUTMP = WS_YS;
static_assert(WS_GUTMP + (size_t)PROWS * 2048 * 4 <= WS_END, "gutmp overlay");
static_assert(WS_V - WS_K == WS_K - WS_Q, "Q/K/V equally spaced");
constexpr int CW_COUNTS = 64;
constexpr int CW_BAR = 4096;
#define XCD_BAR_WORDS 3456
constexpr int MAX_LAUNCH = 24;
static_assert((CW_BAR + MAX_LAUNCH * XCD_BAR_WORDS) * 4 <= (int)(1 * MiB), "ctl words");

constexpr int RING_BYTES = 131072;
constexpr int LDSX_OFF = RING_BYTES;
constexpr int LDS_BYTES = 147456;
constexpr int LX_MISC = LDSX_OFF;
constexpr int LX_TSTART = LDSX_OFF + 64;
constexpr int LX_CNT = LX_TSTART + 160;
constexpr int LX_TILEE = LX_CNT + 128;
constexpr int LX_IDX = LX_TILEE + 1280;
constexpr int LX_BIAS = LX_IDX + 10 * 256 * 4;
static_assert(LX_BIAS + 8 * 256 <= LDS_BYTES, "lds map");
constexpr int NWAVES = 8;

namespace pg8 {
#define PG8_LAS __attribute__((address_space(3)))
typedef unsigned short bf16_t;
typedef unsigned u32x4 __attribute__((ext_vector_type(4)));
constexpr int BM = 256, BK = 64, HALF = 128, HTB = HALF * BK * 2, STAGE_BYTES = 8 * HTB, NXCD = 8, WGM = 4;
__host__ __device__ __forceinline__ int lds_byte(int r, int c) { const int st = (r >> 4) * 2 + (c >> 5), rr = r & 15, cc = c & 31, ob = rr * 64 + cc * 2; return st * 1024 + (ob ^ (((ob >> 9) & 1) << 5)); }
__host__ __device__ __forceinline__ void stage_rc(int b, int& R, int& C) { const int st = b / 1024, sb = b % 1024, swz = sb ^ (((sb >> 9) & 1) << 5); R = (st >> 1) * 16 + swz / 64; C = (st & 1) * 32 + (swz % 64) / 2; }
#define PG8_PQ(fq) ((((fq) & 1) << 1) | ((fq) >> 1))
__host__ __device__ __forceinline__ int perm32(int rho) { const int n = rho >> 4, i = rho & 15; return 8 * PG8_PQ(i >> 2) + 4 * n + (i & 3); }
struct Unit { int pm, pn, e; };
typedef int v4i_t __attribute__((ext_vector_type(4)));
typedef int v8i_t __attribute__((ext_vector_type(8)));
__device__ __forceinline__ unsigned cvt_pk_bf16(float lo, float hi) { unsigned r; asm volatile("v_cvt_pk_bf16_f32 %0, %1, %2" : "=v"(r) : "v"(lo), "v"(hi)); return r; }

struct DenseOrder {
    static constexpr bool GATHER = false;
    int nM, nN, nwg, G, c, K; const char* A; const char* Bt;
    __device__ void init(const bf16_t* A_, const bf16_t* Bt_, int M, int N, int K_, int G_, int c_) { A = (const char*)A_; Bt = (const char*)Bt_; nM = M / BM; nN = N / BM; nwg = nM * nN; G = G_; c = c_; K = K_; }
    __device__ bool next(int i, Unit& u) const {
        const long L = (long)i * G + c; if (L >= nwg) return false;
        int wgid = (int)L; { const int q = nwg / NXCD, r = nwg % NXCD, xcd = wgid % NXCD, off = wgid / NXCD; wgid = (xcd < r ? xcd * (q + 1) : r * (q + 1) + (xcd - r) * q) + off; }
        const int nig = WGM * nN, gid = wgid / nig, fm = gid * WGM, gsz = (nM - fm) < WGM ? (nM - fm) : WGM;
        u.pm = fm + ((wgid % nig) % gsz); u.pn = (wgid % nig) / gsz; u.e = 0; return true;
    }
    __device__ __forceinline__ const char* a_base(const Unit& u) const { return A + (size_t)u.pm * BM * K * 2; }
    __device__ __forceinline__ const char* b_base(const Unit& u) const { return Bt + (size_t)u.pn * BM * K * 2; }
    __device__ __forceinline__ unsigned a_off(int, int) const { return 0u; }
};
struct GroupedOrder {
    int ntiles, G, c, K; const char* A; const char* Bt; const PG8_LAS int* tile_e; const PG8_LAS int* idx;
    __device__ bool next(int i, Unit& u) const {
        const int x = c & 7, j = c >> 3, per = G >> 6, span = (ntiles + 7) >> 3, lo = x * span, off = i * per + (j >> 3), mt = lo + off;
        if (off >= span || mt >= ntiles) return false;
        u.pm = mt; u.pn = j & 7; u.e = tile_e[mt]; return true;
    }
    __device__ __forceinline__ const char* b_base(const Unit& u) const { return Bt + ((size_t)u.e * 2048 + (size_t)u.pn * BM) * K * 2; }
};
struct GroupedGather : GroupedOrder {
    static constexpr bool GATHER = true;
    __device__ __forceinline__ const char* a_base(const Unit&) const { return A; }
    __device__ __forceinline__ unsigned a_off(int ui, int r) const { return (unsigned)idx[ui * 256 + r] * (unsigned)(K * 2); }
};
struct GroupedDense : GroupedOrder {
    static constexpr bool GATHER = false;
    __device__ __forceinline__ const char* a_base(const Unit& u) const { return A + (size_t)u.pm * BM * K * 2; }
    __device__ __forceinline__ unsigned a_off(int, int) const { return 0u; }
};

template <class Epi, class Sched, bool ALIGN_EPI, bool FP8 = false>
__device__ __forceinline__ void gemm_phase(PG8_LAS unsigned char* lds, int K, const Sched& S, const Epi& E) {
    constexpr bool GATHER = Sched::GATHER, RELAX = true;
    int tid_l = threadIdx.x; asm volatile("" : "+v"(tid_l));
    const int tid = tid_l, wid = __builtin_amdgcn_readfirstlane(tid >> 6), lane = tid & 63, wr = wid >> 2, wc = wid & 3, fr = lane & 15, fq = lane >> 4;
    const int nt = K / BK;
    unsigned voffB[2], vAc0[2], vAc1[2], vAn0[2], vAn1[2]; int sR[2], sC[2];
#pragma unroll
    for (int i = 0; i < 2; ++i) { int R, C; stage_rc(tid * 16 + i * 8192, R, C); const int Rb = Epi::PERM ? ((R & ~31) + perm32(R & 31)) : R; sR[i] = R; sC[i] = C;
        voffB[i] = (unsigned)(Rb * K + C) * 2u; vAc0[i] = vAc1[i] = vAn0[i] = vAn1[i] = (unsigned)(R * K + C) * 2u; }
    const size_t kstep = (size_t)(BK * 2);
    const size_t hstep = (size_t)HALF * K * 2;
    const size_t hstepA = GATHER ? 0 : hstep;
    const unsigned ldsw = (unsigned)wid * 1024u;
    const int aoff = lds_byte(wr * 64 + fr, fq * 8), boff = lds_byte(wc * 32 + fr, fq * 8);
#define PG8_SA(b, h) (((b) * 2 + (h)) * HTB)
#define PG8_SB(b, h) ((4 + (b) * 2 + (h)) * HTB)
#define PG8_STAGE(bufoff, gbase, voff) do { _Pragma("unroll") for (int _i = 0; _i < 2; ++_i) \
        __builtin_amdgcn_global_load_lds((const unsigned*)((const char*)(gbase) + (voff)[_i]), (PG8_LAS unsigned*)(lds + (bufoff) + ldsw + _i * 8192), 16, 0, 0); } while (0)
#define PG8_LD2(dst, addr) do { const v4i_t lo_ = *(const PG8_LAS v4i_t*)(addr), hi_ = *(const PG8_LAS v4i_t*)((addr) + 1024); dst = __builtin_shufflevector(lo_, hi_, 0, 1, 2, 3, 4, 5, 6, 7); } while (0)
#define PG8_LDA(dst, b, h) do { _Pragma("unroll") for (int m = 0; m < 4; ++m) PG8_LD2(dst[m], lds + PG8_SA(b, h) + aoff + m * 2048); } while (0)
#define PG8_LDB(dst, b, h) do { _Pragma("unroll") for (int n = 0; n < 2; ++n) PG8_LD2(dst[n], lds + PG8_SB(b, h) + boff + n * 2048); } while (0)
#define PG8_LO(x) __builtin_bit_cast(bf16x8, __builtin_shufflevector(x, x, 0, 1, 2, 3))
#define PG8_HI(x) __builtin_bit_cast(bf16x8, __builtin_shufflevector(x, x, 4, 5, 6, 7))
#define PG8_MMA(ai, bj, At, Bt) do { __builtin_amdgcn_s_setprio(1); _Pragma("unroll") for (int m = 0; m < 4; ++m) _Pragma("unroll") for (int n = 0; n < 2; ++n) { \
        if constexpr (FP8) asm volatile("v_mfma_f32_16x16x128_f8f6f4 %0, %1, %2, %0" : "+v"(acc[ai][bj][m][n]) : "v"(Bt[n]), "v"(At[m]));   \
        else { acc[ai][bj][m][n] = __builtin_amdgcn_mfma_f32_16x16x32_bf16(PG8_LO(Bt[n]), PG8_LO(At[m]), acc[ai][bj][m][n], 0, 0, 0); acc[ai][bj][m][n] = __builtin_amdgcn_mfma_f32_16x16x32_bf16(PG8_HI(Bt[n]), PG8_HI(At[m]), acc[ai][bj][m][n], 0, 0, 0); } } __builtin_amdgcn_s_setprio(0); } while (0)
#define PG8_WAIT_V(n) asm volatile("s_waitcnt vmcnt(" #n ")" ::: "memory")
#define PG8_WAIT_L(n) asm volatile("s_waitcnt lgkmcnt(" #n ")" ::: "memory")
#define PG8_BAR __builtin_amdgcn_s_barrier()
#define PG8_SCHED __builtin_amdgcn_sched_barrier(0)
    Unit cur, nxt; int ui = 0;
    if (!S.next(0, cur)) return;
    f32x4 acc[2][2][4][2];
#pragma unroll
    for (int a = 0; a < 2; ++a)
#pragma unroll
        for (int b = 0; b < 2; ++b)
#pragma unroll
            for (int m = 0; m < 4; ++m)
#pragma unroll
                for (int n = 0; n < 2; ++n) acc[a][b][m][n] = (f32x4){0.f, 0.f, 0.f, 0.f};
    v8i_t At[4], B0[2], B1[2];
    const char* cA = S.a_base(cur); const char* cB = S.b_base(cur);
    if constexpr (GATHER) {
#pragma unroll
        for (int i = 0; i < 2; ++i) { vAc0[i] = S.a_off(0, sR[i]) + (unsigned)sC[i] * 2u; vAc1[i] = S.a_off(0, 128 + sR[i]) + (unsigned)sC[i] * 2u; }
    }
    PG8_STAGE(PG8_SB(0, 0), cB, voffB); PG8_STAGE(PG8_SB(0, 1), cB + hstep, voffB); PG8_STAGE(PG8_SA(0, 0), cA, vAc0); PG8_STAGE(PG8_SA(0, 1), cA + hstepA, vAc1);
    if (wr == 1) PG8_BAR;
    PG8_WAIT_V(2); PG8_BAR;
    PG8_STAGE(PG8_SB(1, 0), cB + kstep, voffB); PG8_STAGE(PG8_SA(1, 0), cA + kstep, vAc0); PG8_STAGE(PG8_SB(1, 1), cB + hstep + kstep, voffB);
    PG8_WAIT_V(6); PG8_BAR;
    PG8_STAGE(PG8_SA(1, 1), cA + kstep + hstepA, vAc1);
    for (;;) {
        E.prefetch(cur, wid, wc, lane);
        const bool has_next = S.next(ui + 1, nxt);
        const char* nA = has_next ? S.a_base(nxt) : cA; const char* nB = has_next ? S.b_base(nxt) : cB;
        if constexpr (GATHER) {
#pragma unroll
            for (int i = 0; i < 2; ++i) { vAn0[i] = has_next ? S.a_off(ui + 1, sR[i]) + (unsigned)sC[i] * 2u : vAc0[i]; vAn1[i] = has_next ? S.a_off(ui + 1, 128 + sR[i]) + (unsigned)sC[i] * 2u : vAc1[i]; }
        }
#define PG8_WAIT_F() asm volatile("s_cmp_eq_u32 %0, 0\n\ts_cbranch_scc0 1f\n\ts_waitcnt vmcnt(8)\n1:\n\ts_waitcnt vmcnt(%1)" ::"s"(first), "n"(8 + Epi::NVM) : "memory", "scc")
        for (int t = 0; t < nt; t += 2) {
            const bool last = (t == nt - 2); const int first = __builtin_amdgcn_readfirstlane((RELAX && t == 0 && ui > 0) ? 1 : 0);
            const char* a2 = last ? nA : cA + (size_t)(t + 2) * kstep; const char* b2 = last ? nB : cB + (size_t)(t + 2) * kstep;
            const char* a3 = a2 + kstep; const char* b3 = b2 + kstep;
            unsigned w0[2], w1[2];
#pragma unroll
            for (int i = 0; i < 2; ++i) { w0[i] = (GATHER && last) ? vAn0[i] : vAc0[i]; w1[i] = (GATHER && last) ? vAn1[i] : vAc1[i]; }
            PG8_LDB(B0, 0, 0); PG8_LDB(B1, 0, 1); PG8_SCHED; PG8_LDA(At, 0, 0);
            PG8_WAIT_F(); PG8_WAIT_L(0); PG8_BAR; PG8_MMA(0, 0, At, B0); PG8_MMA(0, 1, At, B1); PG8_BAR; PG8_SCHED;
            PG8_STAGE(PG8_SB(0, 0), b2, voffB); PG8_STAGE(PG8_SB(0, 1), b2 + hstep, voffB); PG8_STAGE(PG8_SA(0, 0), a2, w0); PG8_LDA(At, 0, 1);
            PG8_WAIT_F(); PG8_WAIT_L(0); PG8_BAR; PG8_MMA(1, 0, At, B0); PG8_MMA(1, 1, At, B1); PG8_BAR; PG8_SCHED;
            PG8_STAGE(PG8_SA(0, 1), a2 + hstepA, w1); PG8_LDB(B0, 1, 0); PG8_LDB(B1, 1, 1); PG8_SCHED; PG8_LDA(At, 1, 0);
            PG8_WAIT_F(); PG8_WAIT_L(0); PG8_BAR; PG8_MMA(0, 0, At, B0); PG8_MMA(0, 1, At, B1); PG8_BAR; PG8_SCHED;
            PG8_STAGE(PG8_SB(1, 0), b3, voffB); PG8_STAGE(PG8_SB(1, 1), b3 + hstep, voffB); PG8_STAGE(PG8_SA(1, 0), a3, w0); PG8_LDA(At, 1, 1);
            PG8_WAIT_V(8); PG8_WAIT_L(0); PG8_BAR; PG8_MMA(1, 0, At, B0); PG8_MMA(1, 1, At, B1); PG8_BAR; PG8_SCHED;
            PG8_STAGE(PG8_SA(1, 1), a3 + hstepA, w1);
        }
        if constexpr (ALIGN_EPI) { if (wr == 0) PG8_BAR; }
        if constexpr (FP8) { asm volatile("s_nop 15\n\ts_nop 15\n\ts_nop 15" ::: "memory"); }
        E(acc, cur, wr, wc, fr, fq);
        if (!has_next) break;
#pragma unroll
        for (int a = 0; a < 2; ++a)
#pragma unroll
            for (int b = 0; b < 2; ++b)
#pragma unroll
                for (int m = 0; m < 4; ++m)
#pragma unroll
                    for (int n = 0; n < 2; ++n) acc[a][b][m][n] = (f32x4){0.f, 0.f, 0.f, 0.f};
        cur = nxt; cA = nA; cB = nB; ++ui;
        if constexpr (GATHER) {
#pragma unroll
            for (int i = 0; i < 2; ++i) { vAc0[i] = vAn0[i]; vAc1[i] = vAn1[i]; }
        }
        if constexpr (ALIGN_EPI) { if (wr == 1) PG8_BAR; }
    }
    PG8_WAIT_V(0);
    if constexpr (!ALIGN_EPI) { if (wr == 0) PG8_BAR; }
    PG8_BAR;
#undef PG8_SA
#undef PG8_SB
#undef PG8_STAGE
#undef PG8_LDA
#undef PG8_LDB
#undef PG8_MMA
#undef PG8_LO
#undef PG8_HI
#undef PG8_LD2
#undef PG8_WAIT_V
#undef PG8_WAIT_F
#undef PG8_WAIT_L
#undef PG8_BAR
#undef PG8_SCHED
}

struct EpiInProj {
    static constexpr bool PERM = true; static constexpr int NVM = 16;
    bf16_t* Q; size_t qkv_stride; bf16_t* PCG; float* kmean; float scale;
    __device__ __forceinline__ void prefetch(const Unit&, int, int, int) const {}
    __device__ __forceinline__ void operator()(const f32x4 (&acc)[2][2][4][2], const Unit& u, int wr, int wc, int fr, int fq) const {
        const int b = u.pm >> 3, sblk = u.pm & 7, dcol = wc * 32 + 8 * PG8_PQ(fq);
        if (u.pn < 12) {
            const int which = u.pn >> 2; bf16_t* base = Q + (size_t)which * qkv_stride;
#pragma unroll
            for (int bj = 0; bj < 2; ++bj) { const int head = (u.pn & 3) * 2 + bj;
                bf16_t* hp = base + ((size_t)(b * 8 + head) * 2048 + sblk * 256 + wr * 64 + fr) * 128 + dcol;
#pragma unroll
                for (int ai = 0; ai < 2; ++ai)
#pragma unroll
                    for (int m = 0; m < 4; ++m) { const f32x4 v0 = acc[ai][bj][m][0] * scale, v1 = acc[ai][bj][m][1] * scale; u32x4 w;
                        w.x = cvt_pk_bf16(v0[0], v0[1]); w.y = cvt_pk_bf16(v0[2], v0[3]); w.z = cvt_pk_bf16(v1[0], v1[1]); w.w = cvt_pk_bf16(v1[2], v1[3]);
                        *(u32x4*)(hp + (size_t)(ai * 128 + m * 16) * 128) = w; }
                if (which == 1) {
#pragma unroll
                    for (int n = 0; n < 2; ++n) { f32x4 cs = (f32x4){0.f, 0.f, 0.f, 0.f};
#pragma unroll
                        for (int ai = 0; ai < 2; ++ai)
#pragma unroll
                            for (int m = 0; m < 4; ++m) cs += acc[ai][bj][m][n];
#pragma unroll
                        for (int q = 0; q < 4; ++q) { float v = cs[q] * scale; v += __shfl_xor(v, 1); v += __shfl_xor(v, 2); v += __shfl_xor(v, 4); v += __shfl_xor(v, 8);
                            if (fr == 0) __hip_atomic_fetch_add(kmean + ((size_t)(b * 8 + head) * 8 + sblk) * 128 + dcol + 4 * n + q, v, __ATOMIC_RELAXED, __HIP_MEMORY_SCOPE_AGENT); } }
                }
            }
        } else {
            const int col0 = (u.pn - 12) * 256 + dcol;
#pragma unroll
            for (int ai = 0; ai < 2; ++ai)
#pragma unroll
                for (int m = 0; m < 4; ++m) { bf16_t* rowp = PCG + (size_t)(u.pm * 256 + ai * 128 + wr * 64 + m * 16 + fr) * 2048 + col0;
#pragma unroll
                    for (int bj = 0; bj < 2; ++bj) { const f32x4 v0 = acc[ai][bj][m][0] * scale, v1 = acc[ai][bj][m][1] * scale; u32x4 w;
                        w.x = cvt_pk_bf16(v0[0], v0[1]); w.y = cvt_pk_bf16(v0[2], v0[3]); w.z = cvt_pk_bf16(v1[0], v1[1]); w.w = cvt_pk_bf16(v1[2], v1[3]);
                        *(u32x4*)(rowp + bj * 128) = w; } }
        }
    }
};
struct EpiPlain {
    static constexpr bool PERM = true; static constexpr int NVM = 16;
    bf16_t* O; int ldc; const float* bias; float scale;
    __device__ __forceinline__ void prefetch(const Unit&, int, int, int) const {}
    __device__ __forceinline__ void operator()(const f32x4 (&acc)[2][2][4][2], const Unit& u, int wr, int wc, int fr, int fq) const {
        const int col0 = u.pn * 256 + wc * 32 + 8 * PG8_PQ(fq);
        f32x4 bv[2][2];
#pragma unroll
        for (int bj = 0; bj < 2; ++bj)
#pragma unroll
            for (int n = 0; n < 2; ++n) bv[bj][n] = bias ? *(const f32x4*)(bias + (size_t)u.e * 2048 + col0 + bj * 128 + 4 * n) : (f32x4){0.f, 0.f, 0.f, 0.f};
#pragma unroll
        for (int ai = 0; ai < 2; ++ai)
#pragma unroll
            for (int m = 0; m < 4; ++m) { bf16_t* rowp = O + (size_t)(u.pm * 256 + ai * 128 + wr * 64 + m * 16 + fr) * ldc + col0;
#pragma unroll
                for (int bj = 0; bj < 2; ++bj) { const f32x4 v0 = acc[ai][bj][m][0] * scale + bv[bj][0], v1 = acc[ai][bj][m][1] * scale + bv[bj][1]; u32x4 w;
                    w.x = cvt_pk_bf16(v0[0], v0[1]); w.y = cvt_pk_bf16(v0[2], v0[3]); w.z = cvt_pk_bf16(v1[0], v1[1]); w.w = cvt_pk_bf16(v1[2], v1[3]);
                    *(u32x4*)(rowp + bj * 128) = w; } }
    }
};
struct EpiPlain8 {
    static constexpr bool PERM = true; static constexpr int NVM = 9;
    unsigned char* O; const float* bias; float scale; PG8_LAS float* bl;
    __device__ __forceinline__ void prefetch(const Unit& u, int wid, int wc, int lane) const {
        __builtin_amdgcn_global_load_lds((const unsigned*)(bias + (size_t)u.e * 2048 + u.pn * 256 + wc * 32 + (lane >> 5) * 128 + (lane & 31)), (PG8_LAS unsigned*)(bl + wid * 64), 4, 0, 0); }
    __device__ __forceinline__ void operator()(const f32x4 (&acc)[2][2][4][2], const Unit& u, int wr, int wc, int fr, int fq) const {
        const int col0 = u.pn * 256 + wc * 32 + 8 * PG8_PQ(fq);
        const PG8_LAS float* bs = bl + (wr * 4 + wc) * 64 + 8 * PG8_PQ(fq);
        f32x4 bv[2][2];
#pragma unroll
        for (int bj = 0; bj < 2; ++bj)
#pragma unroll
            for (int n = 0; n < 2; ++n) bv[bj][n] = *(const PG8_LAS f32x4*)(bs + bj * 32 + 4 * n);
        const bool up_ = fq >= 2; const int cst = up_ ? col0 + 128 - 8 : col0;
#pragma unroll
        for (int ai = 0; ai < 2; ++ai)
#pragma unroll
            for (int m = 0; m < 4; ++m) { unsigned char* rowp = O + (size_t)(u.pm * 256 + ai * 128 + wr * 64 + m * 16 + fr) * 2048 + cst;
                v2u w[2];
#pragma unroll
                for (int bj = 0; bj < 2; ++bj) { const f32x4 v0 = acc[ai][bj][m][0] * scale + bv[bj][0], v1 = acc[ai][bj][m][1] * scale + bv[bj][1];
                    w[bj].x = pk4_fp8(v0[0], v0[1], v0[2], v0[3]); w[bj].y = pk4_fp8(v1[0], v1[1], v1[2], v1[3]); }
                const auto rx = __builtin_amdgcn_permlane32_swap(w[0].x, w[1].x, false, false), ry = __builtin_amdgcn_permlane32_swap(w[0].y, w[1].y, false, false);
                *(u32x4*)rowp = (u32x4){rx[0], ry[0], rx[1], ry[1]}; }
    }
};
__device__ __forceinline__ f32x4 swiglu4(f32x4 g, f32x4 u1) {
    f32x4 e, r;
#pragma unroll
    for (int q = 0; q < 4; ++q) { g[q] = __builtin_fminf(g[q], 7.f); u1[q] = __builtin_amdgcn_fmed3f(u1[q], -6.f, 8.f); }
    const f32x4 a = g * (-1.702f * 1.4426950408889634f);
#pragma unroll
    for (int q = 0; q < 4; ++q) e[q] = __builtin_amdgcn_exp2f(a[q]);
    const f32x4 d = e + 1.f;
#pragma unroll
    for (int q = 0; q < 4; ++q) r[q] = __builtin_amdgcn_rcpf(d[q]);
    return (g * r) * u1;
}
__device__ __forceinline__ unsigned pk4_fp8_nc(f32x4 v) {
    const unsigned w = __builtin_amdgcn_cvt_pk_fp8_f32(v[0], v[1], 0, false); return __builtin_amdgcn_cvt_pk_fp8_f32(v[2], v[3], w, true); }
struct EpiGU {
    static constexpr bool PERM = true; static constexpr int NVM = 5;
    unsigned char* act; const float* bg; const float* bu; float scale; PG8_LAS float* bl;
    __device__ __forceinline__ void prefetch(const Unit& u, int wid, int wc, int lane) const {
        __builtin_amdgcn_global_load_lds((const unsigned*)((lane < 32 ? bg : bu) + (size_t)u.e * 1024 + u.pn * 128 + wc * 32 + (lane & 31)), (PG8_LAS unsigned*)(bl + wid * 64), 4, 0, 0); }
    __device__ __forceinline__ void operator()(const f32x4 (&acc)[2][2][4][2], const Unit& u, int wr, int wc, int fr, int fq) const {
        const int j0 = u.pn * 128 + wc * 32 + 8 * PG8_PQ(fq);
        const PG8_LAS float* bs = bl + (wr * 4 + wc) * 64 + 8 * PG8_PQ(fq);
        f32x4 gv[2], uv[2];
#pragma unroll
        for (int n = 0; n < 2; ++n) { gv[n] = *(const PG8_LAS f32x4*)(bs + 4 * n); uv[n] = *(const PG8_LAS f32x4*)(bs + 32 + 4 * n) + 1.f; }
        const bool up_ = fq >= 2; const int cst = up_ ? j0 - 8 : j0;
#pragma unroll
        for (int ai = 0; ai < 2; ++ai)
#pragma unroll
            for (int mp = 0; mp < 2; ++mp) { v2u w[2];
#pragma unroll
                for (int mm = 0; mm < 2; ++mm) { const int m = 2 * mp + mm;
                    w[mm].x = pk4_fp8_nc(swiglu4(acc[ai][0][m][0] * scale + gv[0], acc[ai][1][m][0] * scale + uv[0]));
                    w[mm].y = pk4_fp8_nc(swiglu4(acc[ai][0][m][1] * scale + gv[1], acc[ai][1][m][1] * scale + uv[1])); }
                const auto rx = __builtin_amdgcn_permlane32_swap(w[0].x, w[1].x, false, false), ry = __builtin_amdgcn_permlane32_swap(w[0].y, w[1].y, false, false);
                *(u32x4*)(act + (size_t)(u.pm * 256 + ai * 128 + wr * 64 + (2 * mp + (up_ ? 1 : 0)) * 16 + fr) * 1024 + cst) = (u32x4){rx[0], ry[0], rx[1], ry[1]}; }
    }
};
}

#define XB_TMO      128
#define XB_XCNT(j)  (256  + 64 * (j))
#define XB_XSUB(j)  (1280 + 64 * (j))
#define XB_XGEN(j)  (2304 + 64 * (j))
#define XB_TOP      3328
#define XB_TOPGEN   3392
#define XB_SPIN_CAP (1u << 18)
__device__ __forceinline__ unsigned xb_ld(unsigned* p)              { return __hip_atomic_load(p, __ATOMIC_RELAXED, __HIP_MEMORY_SCOPE_AGENT); }
__device__ __forceinline__ unsigned xb_add(unsigned* p, unsigned v) { return __hip_atomic_fetch_add(p, v, __ATOMIC_RELAXED, __HIP_MEMORY_SCOPE_AGENT); }
__device__ __forceinline__ unsigned xb_xcc_id() { return (unsigned)__builtin_amdgcn_s_getreg((3 << 11) | 20) & 0xFu; }
#define XB_SPIN(cond, bar) do { unsigned _sp = 0; while (cond) { __builtin_amdgcn_s_sleep(1); \
    if ((++_sp & 255u) == 0u) { if (xb_ld(&(bar)[XB_TMO])) break; if (_sp > XB_SPIN_CAP) { atomicAdd(&(bar)[XB_TMO], 1u); break; } } } } while (0)
struct XcdBarrier { unsigned* bar; unsigned x; volatile LAS unsigned* st; };
__device__ __forceinline__ XcdBarrier xcd_barrier_post(unsigned* bar, volatile LAS unsigned* st) {
    XcdBarrier b; b.bar = bar; b.x = xb_xcc_id(); b.st = st;
    if (threadIdx.x == 0) (void)xb_add(&bar[XB_XCNT(b.x)], 1u);
    return b;
}
__device__ __forceinline__ void xcd_barrier_complete(unsigned* bar, unsigned x, unsigned& nloc, unsigned& nx) {
    const unsigned G = gridDim.x * gridDim.y * gridDim.z;
    unsigned sum, cnt, mine, sp = 0u;
    for (;;) {
        sum = 0u; cnt = 0u; mine = 0u;
#pragma unroll
        for (unsigned j = 0; j < 16; ++j) { const unsigned c = xb_ld(&bar[XB_XCNT(j)]); sum += c; cnt += (c > 0u) ? 1u : 0u; mine = (j == x) ? c : mine; }
        if (sum == G) break;
        __builtin_amdgcn_s_sleep(1);
        if ((++sp & 255u) == 0u) { if (xb_ld(&bar[XB_TMO])) break; if (sp > XB_SPIN_CAP) { atomicAdd(&bar[XB_TMO], 1u); break; } }
    }
    nloc = mine > 0u ? mine : 1u; nx = cnt > 0u ? cnt : 1u;
}
__device__ __forceinline__ void xcd_barrier(const XcdBarrier& b) {
    asm volatile("s_waitcnt vmcnt(0)" ::: "memory");
    __syncthreads();
    if (threadIdx.x == 0) {
        unsigned* bar = b.bar;
        __builtin_amdgcn_s_waitcnt(0);
        unsigned nloc = b.st[0], nx = b.st[1];
        if (nloc == 0u) { xcd_barrier_complete(bar, b.x, nloc, nx); b.st[0] = nloc; b.st[1] = nx; }
        const unsigned old = xb_add(&bar[XB_XSUB(b.x)], 1u);
        const unsigned gen = old / nloc;
        if (old + 1u == (gen + 1u) * nloc) {
            __builtin_amdgcn_fence(__ATOMIC_RELEASE, "agent");
            asm volatile("s_waitcnt vmcnt(0)" ::: "memory");
            const unsigned og = xb_add(&bar[XB_TOP], 1u);
            const unsigned tg = og / nx;
            if (og + 1u == (tg + 1u) * nx) xb_add(&bar[XB_TOPGEN], 1u);
            else XB_SPIN(xb_ld(&bar[XB_TOPGEN]) == tg, bar);
            __builtin_amdgcn_fence(__ATOMIC_ACQUIRE, "agent");
            xb_add(&bar[XB_XGEN(b.x)], 1u);
            asm volatile("s_waitcnt vmcnt(0)" ::: "memory");
        } else {
            XB_SPIN(xb_ld(&bar[XB_XGEN(b.x)]) == gen, bar);
            __builtin_amdgcn_fence(__ATOMIC_ACQUIRE, "agent");
            asm volatile("s_waitcnt vmcnt(0)" ::: "memory");
        }
    }
    __syncthreads();
}

struct Args { const float* in[22]; float* out; unsigned char* ws; int ph_lo, ph_hi, li, pad; };
enum { I_X = 0, I_C, I_WADA, I_BADA, I_GPREM, I_GPOSTM, I_GPREF, I_GPOSTF, I_WIN, I_WOUT, I_POOLW, I_POOLS, I_CONVW, I_RELB, I_RW, I_RB, I_WG, I_BG, I_WU, I_BU, I_WD, I_BD };

__device__ __forceinline__ float wave_sum(float v) {
#pragma unroll
    for (int o = 1; o < 64; o <<= 1) v += __shfl_xor(v, o);
    return v;
}
__device__ __forceinline__ float wave_max(float v) {
#pragma unroll
    for (int o = 1; o < 64; o <<= 1) v = fmaxf(v, __shfl_xor(v, o));
    return v;
}
__device__ __forceinline__ float silu(float x) { return x / (1.f + __expf(-x)); }

template <int NSET>
__device__ __forceinline__ void weight_transposes(const Args& a, LAS unsigned char* lds, int gw, int NGW, int wave, int lane_in, int lE, int lP) {
    int lane = lane_in; asm volatile("" : "+v"(lane));
    unsigned char* ws = a.ws;
    constexpr int SU_G = NE * 8 * 32, SU_D = NE * 4 * 64, SU_O = 8 * 64, SU_I = 8 * 144;
    const int SU_E = lE >= 0 ? 2 * SU_G + SU_D : 0, SU_ALL = SU_E + (lP >= 0 ? SU_O + SU_I : 0);
    struct SDesc { const float* src; unsigned char* dst; int N, pitch; };
    auto decode = [&](int it) -> SDesc {
        SDesc d; int r = it;
        if (r < SU_E) {
        if (r < 2 * SU_G) { const int up = r >= SU_G; if (up) r -= SU_G;
            const int nb = r & 31, kq = (r >> 5) & 7, le = lE * NE + (r >> 8), n0 = nb * 32, k0 = kq * 256;
            d.src = a.in[up ? I_WU : I_WG] + (size_t)le * D * DE + (size_t)k0 * DE + n0; d.N = DE; d.pitch = D;
            d.dst = ws + WS_WGU + ((size_t)le * 2048 + (n0 >> 7) * 256 + up * 128 + (n0 & 127)) * D + k0; return d; }
        r -= 2 * SU_G;
        { const int nb = r & 63, kq = (r >> 6) & 3, le = lE * NE + (r >> 8), n0 = nb * 32, k0 = kq * 256;
            d.src = a.in[I_WD] + (size_t)le * DE * D + (size_t)k0 * D + n0; d.N = D; d.pitch = DE;
            d.dst = ws + WS_WDN + ((size_t)le * 2048 + n0) * DE + k0; return d; } }
        r -= SU_E; const int l = lP;
        if (r < SU_O) { const int nb = r & 63, kq = (r >> 6) & 7, n0 = nb * 32, k0 = kq * 256;
            d.src = a.in[I_WOUT] + (size_t)l * D * D + (size_t)k0 * D + n0; d.N = D; d.pitch = D;
            d.dst = ws + WS_WOUT + ((size_t)l * D + n0) * D + k0; return d; }
        r -= SU_O;
        { const int nq = r % 144, nb = nq < 96 ? nq : nq + 16, kq = r / 144, n0 = nb * 32, k0 = kq * 256;
            d.src = a.in[I_WIN] + (size_t)l * D * DIN + (size_t)k0 * DIN + n0; d.N = DIN; d.pitch = D;
            d.dst = ws + WS_WIN + ((size_t)l * DIN + n0) * D + k0; return d; }
    };
    LAS unsigned char* wb = lds + wave * 16384;
#define SU_LOAD(R, d, sub) do { const unsigned lo_ = (unsigned)(((lane >> 3) * 16 * (d).N + (lane & 7) * 4) * 4);     \
        const char* sb_ = (const char*)((d).src + (size_t)((sub) * 128) * (d).N);                                                                    \
        _Pragma("unroll") for (int j = 0; j < 16; ++j) R[j] = __builtin_nontemporal_load((const f32x4*)(sb_ + (size_t)j * (d).N * 4 + lo_)); } while (0)
#define SU_CONV(R, sub) do { const int r_ = lane >> 3, c4_ = lane & 7;                                                                               \
        _Pragma("unroll") for (int i = 0; i < 4; ++i) { v4u o;                                                                                       \
            o.x = pk4_fp8(R[0][i] * WSCALE, R[1][i] * WSCALE, R[2][i] * WSCALE, R[3][i] * WSCALE); o.y = pk4_fp8(R[4][i] * WSCALE, R[5][i] * WSCALE, R[6][i] * WSCALE, R[7][i] * WSCALE);          \
            o.z = pk4_fp8(R[8][i] * WSCALE, R[9][i] * WSCALE, R[10][i] * WSCALE, R[11][i] * WSCALE); o.w = pk4_fp8(R[12][i] * WSCALE, R[13][i] * WSCALE, R[14][i] * WSCALE, R[15][i] * WSCALE);     \
            *(LAS v4u*)(wb + (c4_ * 4 + i) * 256 + ((((sub) * 8 + r_) ^ c4_) << 4)) = o; } } while (0)
#define SU_OUT(d) do { LDS_WAIT(); asm volatile("" ::: "memory");                                                                                    \
        _Pragma("unroll") for (int q8 = 0; q8 < 8; ++q8) { const int n_ = 4 * q8 + (lane >> 4), c_ = lane & 15;                                     \
            __builtin_nontemporal_store(*(const LAS v4u*)(wb + n_ * 256 + ((c_ ^ ((n_ >> 2) & 7)) << 4)), (v4u*)((d).dst + (size_t)n_ * (d).pitch + c_ * 16)); }                \
        LDS_WAIT(); asm volatile("" ::: "memory"); } while (0)
    if (gw < SU_ALL) {
        const int n2 = 2 * ((SU_ALL - gw + NGW - 1) / NGW);
#define SU_LDQ(R, q) do { if ((q) < n2) { const SDesc d_ = decode(gw + ((q) >> 1) * NGW); SU_LOAD(R, d_, (q) & 1); } asm volatile("" ::: "memory"); } while (0)
#define SU_CVQ(R, q) do { if ((q) < n2) { SU_CONV(R, (q) & 1); if ((q) & 1) { const SDesc d_ = decode(gw + ((q) >> 1) * NGW); SU_OUT(d_); } } asm volatile("" ::: "memory"); } while (0)
        f32x4 RA[16], RB[16];
        if constexpr (NSET == 3) {
            f32x4 RC[16];
            SU_LDQ(RA, 0); SU_LDQ(RB, 1);
            for (int q = 0; q < n2; q += 3) {
                SU_LDQ(RC, q + 2); SU_CVQ(RA, q);
                SU_LDQ(RA, q + 3); SU_CVQ(RB, q + 1);
                SU_LDQ(RB, q + 4); SU_CVQ(RC, q + 2);
            }
        } else {
            SU_LDQ(RA, 0);
            for (int q = 0; q < n2; q += 2) {
                SU_LDQ(RB, q + 1); SU_CVQ(RA, q);
                SU_LDQ(RA, q + 2); SU_CVQ(RB, q + 1);
            }
        }
#undef SU_LDQ
#undef SU_CVQ
    }
#undef SU_LOAD
#undef SU_CONV
#undef SU_OUT
}
__device__ __forceinline__ void p0a(const Args& a, LAS unsigned char* lds, int gw, int NGW, int wave, int lane, int tid) {
    unsigned char* ws = a.ws;
    LAS float* scr = (LAS float*)(lds + wave * 8448);
    LAS float* cact = (LAS float*)lds;
    for (int i = tid; i < 8 * D; i += NWAVES * 64) cact[i] = silu(a.in[I_C][i]);
    __syncthreads();
    for (int it = gw; it < NL * 48 * 16; it += NGW) {
        const int kc = it & 15, nb = (it >> 4) % 48, l = it / (16 * 48);
        const float* W = a.in[I_WADA] + ((size_t)l * D + kc * 128) * NMOD + nb * 256 + lane * 4;
        f32x4 acc[8];
#pragma unroll
        for (int b = 0; b < 8; ++b) acc[b] = (f32x4){0.f, 0.f, 0.f, 0.f};
#pragma unroll 8
        for (int kk = 0; kk < 128; ++kk) { const f32x4 w = *(const f32x4*)(W + (size_t)kk * NMOD);
#pragma unroll
            for (int b = 0; b < 8; ++b) acc[b] += w * cact[b * D + kc * 128 + kk]; }
        float* P = (float*)(ws + WS_MODP) + (((size_t)kc * NL + l) * 8) * NMOD + nb * 256 + lane * 4;
#pragma unroll
        for (int b = 0; b < 8; ++b) *(f32x4*)(P + (size_t)b * NMOD) = acc[b];
    }
    __syncthreads();
    for (int it = gw; it < NL * 4 * 32 * 4; it += NGW) {
        const int jb = it & 3, kb = (it >> 2) & 31, g = (it >> 7) & 3, l = it >> 9;
        const float* Wi = a.in[I_WIN] + ((size_t)l * D + kb * 64 + lane) * DIN + 3072 + g * 128;
        const float* Wp = a.in[I_POOLW] + ((size_t)(l * 4 + g) * 128) * 128 + jb * 32;
        LAS float* wl = (LAS float*)(lds + wave * 16384);
#pragma unroll
        for (int q = 0; q < 16; ++q) { const int c = q * 8 + (lane >> 3), jj = (lane & 7) * 4; *(LAS f32x4*)(wl + c * 32 + jj) = *(const f32x4*)(Wp + (size_t)c * 128 + jj); }
        LDS_WAIT(); asm volatile("" ::: "memory");
        float acc[32];
#pragma unroll
        for (int j2 = 0; j2 < 32; ++j2) acc[j2] = 0.f;
#pragma unroll 4
        for (int c4 = 0; c4 < 32; ++c4) { const f32x4 av = *(const f32x4*)(Wi + 4 * c4);
#pragma unroll
            for (int cc = 0; cc < 4; ++cc) {
#pragma unroll
                for (int j4 = 0; j4 < 8; ++j4) { const f32x4 wv = *(const LAS f32x4*)(wl + (4 * c4 + cc) * 32 + 4 * j4);
                    acc[4 * j4 + 0] += av[cc] * wv.x; acc[4 * j4 + 1] += av[cc] * wv.y; acc[4 * j4 + 2] += av[cc] * wv.z; acc[4 * j4 + 3] += av[cc] * wv.w; } } }
        unsigned char* WT = ws + WS_WIN + ((size_t)l * DIN + 3072 + g * 128 + jb * 32) * D + kb * 64 + lane;
        const float* ps = a.in[I_POOLS] + l * 512 + g * 128 + jb * 32;
#pragma unroll
        for (int j2 = 0; j2 < 32; ++j2) WT[(size_t)j2 * D] = (unsigned char)(pk4_fp8(acc[j2] * ps[j2] * WSCALE, 0.f, 0.f, 0.f) & 0xffu);
        LDS_WAIT(); asm volatile("" ::: "memory");
    }
    for (int i = gw * 64 + lane; i < NL * NE * D; i += NGW * 64) { const int k = i & 2047, n = (i >> 11) & 31, l = i >> 16;
        ((bf16*)(ws + WS_WR))[i] = (bf16)f2bf(a.in[I_RW][((size_t)l * D + k) * NE + n]); }
    weight_transposes<2>(a, lds, gw, NGW, wave, lane, -1, 0);
}
__device__ __forceinline__ void p0b(const Args& a, int gw, int NGW, int lane) {
    const float* P = (const float*)(a.ws + WS_MODP); float* mod = (float*)(a.ws + WS_MOD);
    for (int i = gw * 64 + lane; i < NL * 8 * NMOD; i += NGW * 64) {
        const int n = i % NMOD, l = i / (8 * NMOD);
        float s = a.in[I_BADA][(size_t)l * NMOD + n];
#pragma unroll
        for (int kc = 0; kc < 16; ++kc) s += P[(size_t)kc * NL * 8 * NMOD + i];
        const int ch = n / D, c = n - ch * D;
        if (ch == 1) s = a.in[I_GPREM][l * D + c] * (1.f + s); else if (ch == 2) s *= a.in[I_GPOSTM][l * D + c];
        else if (ch == 4) s = a.in[I_GPREF][l * D + c] * (1.f + s); else if (ch == 5) s *= a.in[I_GPOSTF][l * D + c];
        mod[i] = s;
    }
}
__device__ __forceinline__ void prenorm_store(const f32x4 (&v)[8], const float* gb, const float* sh, bf16* orow, int lane) {
    float ss = 0.f;
#pragma unroll
    for (int j = 0; j < 8; ++j) ss += (v[j].x * v[j].x + v[j].y * v[j].y) + (v[j].z * v[j].z + v[j].w * v[j].w);
    const float r = rsqrtf(wave_sum(ss) * (1.f / D) + EPS);
#pragma unroll
    for (int j = 0; j < 8; ++j) { const int c = 256 * j + 4 * lane;
        const f32x4 h = v[j] * r * *(const f32x4*)(gb + c) + *(const f32x4*)(sh + c);
        v2u o; o.x = pk2(h.x, h.y); o.y = pk2(h.z, h.w);
        *(v2u*)(orow + c) = o; }
}
__device__ __forceinline__ void prenorm_store_lds(const f32x4 (&v)[8], const LAS float* gb, const LAS float* sh, unsigned char* orow, int lane) {
    float ss = 0.f;
#pragma unroll
    for (int j = 0; j < 8; ++j) ss += (v[j].x * v[j].x + v[j].y * v[j].y) + (v[j].z * v[j].z + v[j].w * v[j].w);
    const float r = rsqrtf(wave_sum(ss) * (1.f / D) + EPS);
#pragma unroll
    for (int j = 0; j < 8; ++j) { const int c = 256 * j + 4 * lane;
        const f32x4 h = v[j] * r * *(const LAS f32x4*)(gb + c) + *(const LAS f32x4*)(sh + c);
        *(unsigned*)(orow + c) = pk4_fp8(h.x, h.y, h.z, h.w); }
}
__device__ __forceinline__ void p0c(const Args& a, LAS unsigned char* lds, int gw, int NGW, int lane, int tid) {
    const int rpw = (T + NGW - 1) / NGW, t_first = (gw - (tid >> 6)) * rpw, bA = (t_first < T ? t_first : T - 1) / S;
    LAS float* prm = (LAS float*)lds;
    { const float* P = (const float*)(a.ws + WS_MODP);
      for (int i = tid; i < 2 * 2 * D; i += NWAVES * 64) { const int bb = i / (2 * D), n = i - bb * 2 * D; int b = bA + bb; b = b < NB ? b : NB - 1;
          float sacc = a.in[I_BADA][n];
#pragma unroll
          for (int kc = 0; kc < 16; ++kc) sacc += P[((size_t)kc * NL * 8 + b) * NMOD + n];
          if (n >= D) sacc = a.in[I_GPREM][n - D] * (1.f + sacc);
          prm[i] = sacc; } }
    __syncthreads();
    for (int t0 = gw * rpw; t0 < (gw + 1) * rpw && t0 < T; t0 += 2) {
        f32x4 v[2][8];
#pragma unroll
        for (int q = 0; q < 2; ++q) { const int t = (t0 + q < T && t0 + q < (gw + 1) * rpw) ? t0 + q : t0;
#pragma unroll
            for (int j = 0; j < 8; ++j) v[q][j] = *(const f32x4*)(a.in[I_X] + (size_t)t * D + 256 * j + 4 * lane); }
#pragma unroll
        for (int q = 0; q < 2; ++q) if (t0 + q < T && t0 + q < (gw + 1) * rpw) { const int t = t0 + q; const LAS float* mb = prm + (t / S - bA) * 2 * D;
#pragma unroll
            for (int j = 0; j < 8; ++j) { v2u o; o.x = pk2(v[q][j].x, v[q][j].y); o.y = pk2(v[q][j].z, v[q][j].w); *(v2u*)((bf16*)(a.ws + WS_XB) + (size_t)t * D + 256 * j + 4 * lane) = o; }
            prenorm_store_lds(v[q], mb + D, mb, a.ws + WS_HB + (size_t)t * D, lane); }
    }
}


__device__ __forceinline__ void grouped_prepare(LAS unsigned char* lds, const int* __restrict__ counts, const int* __restrict__ rowtok, bool gather, int G, int c, pg8::GroupedOrder& So) {
    LAS int* tstart = (LAS int*)(lds + LX_TSTART); LAS int* cnt = (LAS int*)(lds + LX_CNT); LAS int* tile_e = (LAS int*)(lds + LX_TILEE); LAS int* idx = (LAS int*)(lds + LX_IDX);
    int tid_l = threadIdx.x; asm volatile("" : "+v"(tid_l));
    const int tid = tid_l;
    __syncthreads();
    if (tid < NE) cnt[tid] = counts[tid];
    __syncthreads();
    if (tid == 0) { int s = 0; for (int e = 0; e < NE; ++e) { tstart[e] = s; s += (cnt[e] + 255) >> 8; } tstart[NE] = s; }
    __syncthreads();
    const int ntiles = tstart[NE];
    for (int g = tid; g < ntiles; g += NWAVES * 64) { int e = 0; for (int k = 1; k < NE; ++k) e = (tstart[k] <= g) ? k : e; tile_e[g] = e; }
    __syncthreads();
    So.ntiles = ntiles; So.G = G; So.c = c; So.tile_e = tile_e; So.idx = idx;
    if (gather) {
        for (int i = 0; i < 10; ++i) { pg8::Unit u; if (!So.next(i, u)) break;
            if (tid < 256) { const int grow = (u.pm - tstart[u.e]) * 256 + tid; idx[i * 256 + tid] = (grow < cnt[u.e]) ? rowtok[(size_t)u.e * T + grow] : 0; } }
    }
    __syncthreads();
}

__device__ __forceinline__ void top4_rows(LAS float* LOGIT, int row, int (&ix)[4], float (&gt)[4]) {
    float v[4];
#pragma unroll
    for (int j = 0; j < 4; ++j) { int best = 0; float bv = -3e38f;
        for (int n = 0; n < NE; ++n) { const float x = LOGIT[row * 32 + n]; if (x > bv) { bv = x; best = n; } }
        v[j] = bv; ix[j] = best; LOGIT[row * 32 + best] = -3.4e38f; }
    float sum = 0.f;
#pragma unroll
    for (int j = 0; j < 4; ++j) { gt[j] = __expf(v[j] - v[0]); sum += gt[j]; }
    const float inv = 1.f / sum;
#pragma unroll
    for (int j = 0; j < 4; ++j) gt[j] *= inv;
}
__device__ __forceinline__ void row1_phase(const Args& a, LAS unsigned char* lds, int l, int G, int bx) {
    int tid_l = threadIdx.x; asm volatile("" : "+v"(tid_l));
    const int tid = tid_l, lane = tid & 63, wave = __builtin_amdgcn_readfirstlane(tid >> 6);
    unsigned char* ws = a.ws;
    const bf16* xinb = (const bf16*)(ws + WS_XB);
    const bf16* mix = (const bf16*)(ws + WS_MIX); unsigned char* hb8 = ws + WS_HB8;
    bf16* xo = (bf16*)(ws + WS_XB);
    const float* modl = (const float*)(ws + WS_MOD) + (size_t)l * 8 * NMOD;
    int* topi = (int*)(ws + WS_ROUT); float* topg = (float*)(ws + WS_ROUT + 256 * 1024); int* toprank = (int*)(ws + WS_ROUT + 512 * 1024);
    int* rowtok = (int*)(ws + WS_ROWTOK); int* counts = (int*)(ws + WS_CTL) + CW_COUNTS + l * 32;
    LAS bf16* H2T = (LAS bf16*)lds;
    LAS float* PART = (LAS float*)(lds + 66048); LAS float* LOGIT = (LAS float*)(lds + 82432);
    LAS int* TOPI_L = (LAS int*)(lds + 84480); LAS int* LR_L = TOPI_L + 512; LAS int* LHIST = LR_L + 512; LAS int* LBASE = LHIST + 32;
    const bf16* Wr = (const bf16*)(ws + WS_WR) + (size_t)l * NE * D;
#define R1_BAR() asm volatile("s_waitcnt lgkmcnt(0)\n\ts_barrier" ::: "memory")
    v2u xr[2][8], mw[2][8];
#define R1_ISSUE(itx) do { _Pragma("unroll") for (int rr = 0; rr < 2; ++rr) { const size_t o_ = (size_t)((itx) * 16 + 2 * wave + rr) * D + 4 * lane;                \
        _Pragma("unroll") for (int j = 0; j < 8; ++j) { xr[rr][j] = *(const v2u*)(xinb + o_ + 256 * j); \
            mw[rr][j] = *(const v2u*)(mix + o_ + 256 * j); } } } while (0)
    const int ipw = (T / 16 + G - 1) / G, itend = (bx + 1) * ipw < T / 16 ? (bx + 1) * ipw : T / 16;
    int nit = 0, it = bx * ipw;
    if (it < itend) R1_ISSUE(it);
    for (; it < itend; ++it, ++nit) {
#pragma unroll
        for (int rr = 0; rr < 2; ++rr) {
            const int r = 2 * wave + rr, t = it * 16 + r;
            const float* mb = modl + (size_t)(t / S) * NMOD;
            f32x4 v[8];
#pragma unroll
            for (int j = 0; j < 8; ++j) v[j] = (f32x4){bflo(xr[rr][j].x), bfhi(xr[rr][j].x), bflo(xr[rr][j].y), bfhi(xr[rr][j].y)};
            float ss = 0.f;
#pragma unroll
            for (int j = 0; j < 8; ++j) { const float y0 = bflo(mw[rr][j].x), y1 = bfhi(mw[rr][j].x), y2 = bflo(mw[rr][j].y), y3 = bfhi(mw[rr][j].y); ss += (y0 * y0 + y1 * y1) + (y2 * y2 + y3 * y3); }
            const float r1 = rsqrtf(wave_sum(ss) * (1.f / D) + EPS);
#pragma unroll
            for (int j = 0; j < 8; ++j) { const int c = 256 * j + 4 * lane;
                const f32x4 y = (f32x4){bflo(mw[rr][j].x), bfhi(mw[rr][j].x), bflo(mw[rr][j].y), bfhi(mw[rr][j].y)};
                v[j] += *(const f32x4*)(mb + 2 * D + c) * (y * r1);
                v2u o; o.x = pk2(v[j].x, v[j].y); o.y = pk2(v[j].z, v[j].w);
                *(v2u*)(xo + (size_t)t * D + c) = o; }
            float s2 = 0.f;
#pragma unroll
            for (int j = 0; j < 8; ++j) s2 += (v[j].x * v[j].x + v[j].y * v[j].y) + (v[j].z * v[j].z + v[j].w * v[j].w);
            const float r2 = rsqrtf(wave_sum(s2) * (1.f / D) + EPS);
#pragma unroll
            for (int j = 0; j < 8; ++j) { const int c = 256 * j + 4 * lane;
                const f32x4 h = v[j] * r2 * *(const f32x4*)(mb + 4 * D + c) + *(const f32x4*)(mb + 3 * D + c);
                v2u o; o.x = pk2(h.x, h.y); o.y = pk2(h.z, h.w);
                *(unsigned*)(hb8 + (size_t)t * D + c) = pk4_fp8(h.x, h.y, h.z, h.w); *(LAS v2u*)(H2T + r * 2056 + c) = o; }
        }
        if (it + 1 < itend) R1_ISSUE(it + 1);
        asm volatile("" ::: "memory");
        bf16x8 wf[8][2];
#pragma unroll
        for (int s = 0; s < 8; ++s)
#pragma unroll
            for (int hf = 0; hf < 2; ++hf) wf[s][hf] = *(const bf16x8*)(Wr + (size_t)(hf * 16 + (lane & 15)) * D + 256 * wave + 32 * s + 8 * (lane >> 4));
        R1_BAR();
        f32x4 acc0 = (f32x4){0.f, 0.f, 0.f, 0.f}, acc1 = (f32x4){0.f, 0.f, 0.f, 0.f};
#pragma unroll
        for (int s = 0; s < 8; ++s) { const bf16x8 af = *(const LAS bf16x8*)(H2T + (lane & 15) * 2056 + 256 * wave + 32 * s + 8 * (lane >> 4));
            acc0 = __builtin_amdgcn_mfma_f32_16x16x32_bf16(af, wf[s][0], acc0, 0, 0, 0); acc1 = __builtin_amdgcn_mfma_f32_16x16x32_bf16(af, wf[s][1], acc1, 0, 0, 0); }
#pragma unroll
        for (int i = 0; i < 4; ++i) { PART[(wave * 16 + 4 * (lane >> 4) + i) * 32 + (lane & 15)] = acc0[i]; PART[(wave * 16 + 4 * (lane >> 4) + i) * 32 + 16 + (lane & 15)] = acc1[i]; }
        R1_BAR();
        { const int row = tid >> 5, e = tid & 31; float sacc = a.in[I_RB][l * NE + e];
#pragma unroll
          for (int w = 0; w < 8; ++w) sacc += PART[(w * 16 + row) * 32 + e];
          LOGIT[row * 32 + e] = sacc; }
        R1_BAR();
        if (tid < 16) { int ix[4]; float gt[4]; top4_rows(LOGIT, tid, ix, gt); const int t = it * 16 + tid;
            *(int4*)(topi + t * 4) = make_int4(ix[0], ix[1], ix[2], ix[3]); *(float4*)(topg + t * 4) = make_float4(gt[0], gt[1], gt[2], gt[3]);
            *(LAS v4u*)(TOPI_L + (nit * 16 + tid) * 4) = (v4u){(unsigned)ix[0], (unsigned)ix[1], (unsigned)ix[2], (unsigned)ix[3]}; }
        R1_BAR();
    }
#undef R1_ISSUE
#undef R1_BAR
    if (tid < 32) LHIST[tid] = 0;
    __syncthreads();
    const int nasg = nit * 64;
    for (int q = tid; q < nasg; q += NWAVES * 64) LR_L[q] = __hip_atomic_fetch_add(LHIST + TOPI_L[q], 1, __ATOMIC_RELAXED, __HIP_MEMORY_SCOPE_WORKGROUP);
    __syncthreads();
    if (tid < 32) { const int n = LHIST[tid]; LBASE[tid] = n ? __hip_atomic_fetch_add(counts + tid, n, __ATOMIC_RELAXED, __HIP_MEMORY_SCOPE_AGENT) : 0; }
    __syncthreads();
    for (int q = tid; q < nasg; q += NWAVES * 64) { const int e = TOPI_L[q], rank = LBASE[e] + LR_L[q], t = (bx * ipw + (q >> 6)) * 16 + ((q >> 2) & 15);
        toprank[t * 4 + (q & 3)] = rank; rowtok[(size_t)e * T + rank] = t; }
}
template <bool LAST>
__device__ __forceinline__ void row2_phase(const Args& a, LAS unsigned char* lds, int l, int gw, int NGW) {
    int tid_l = threadIdx.x; asm volatile("" : "+v"(tid_l));
    const int tid = tid_l, lane = tid & 63;
    unsigned char* ws = a.ws;
    LAS int* SEG = (LAS int*)(lds + LX_TSTART);
    const int* counts = (const int*)(ws + WS_CTL) + CW_COUNTS + l * 32;
    __syncthreads();
    if (tid == 0) { int s = 0; for (int e = 0; e < NE; ++e) { SEG[e] = s; s += (counts[e] + 255) & ~255; } }
    __syncthreads();
    const int* topi = (const int*)(ws + WS_ROUT); const float* topg = (const float*)(ws + WS_ROUT + 256 * 1024); const int* toprank = (const int*)(ws + WS_ROUT + 512 * 1024);
    const unsigned char* ys = ws + WS_YS; unsigned char* hb = ws + WS_HB;
    const bf16* xinb = (const bf16*)(ws + WS_XB); bf16* xob = (bf16*)(ws + WS_XB); float* xo32 = a.out;
    const float* modl = (const float*)(ws + WS_MOD) + (size_t)l * 8 * NMOD;
    const int rpw = (T + NGW - 1) / NGW;
    const int t_first = (gw - (tid >> 6)) * rpw, bA = (t_first < T ? t_first : T - 1) / S;
    LAS float* prm = (LAS float*)lds;
    for (int i = tid * 4; i < 2 * 3 * D; i += NWAVES * 64 * 4) { const int bb = i / (3 * D), r_ = i - bb * 3 * D, k3 = r_ / D, c = r_ - k3 * D; int b = bA + bb; b = b < NB ? b : NB - 1;
        const float* src = (k3 == 0) ? modl + (size_t)b * NMOD + 5 * D : modl + (size_t)8 * NMOD + (size_t)b * NMOD + (k3 == 1 ? D : 0);
        *(LAS f32x4*)(prm + i) = (LAST && k3) ? (f32x4){0.f, 0.f, 0.f, 0.f} : *(const f32x4*)(src + c); }
    __syncthreads();
    for (int t0 = gw * rpw; t0 < (gw + 1) * rpw && t0 < T; t0 += 2) {
        int4 ei[2], rk[2]; float4 gg[2]; bool ok[2];
#pragma unroll
        for (int q = 0; q < 2; ++q) { const int t = t0 + q; ok[q] = t < T && t < (gw + 1) * rpw; const int tt = ok[q] ? t : t0;
            ei[q] = *(const int4*)(topi + tt * 4); rk[q] = *(const int4*)(toprank + tt * 4); gg[q] = *(const float4*)(topg + tt * 4); }
        unsigned yw[2][4][8]; v2u xw[2][8];
#pragma unroll
        for (int q = 0; q < 2; ++q) { const int tt = ok[q] ? t0 + q : t0;
            const unsigned char* y0 = ys + (size_t)(SEG[ei[q].x] + rk[q].x) * D + 4 * lane; const unsigned char* y1 = ys + (size_t)(SEG[ei[q].y] + rk[q].y) * D + 4 * lane;
            const unsigned char* y2 = ys + (size_t)(SEG[ei[q].z] + rk[q].z) * D + 4 * lane; const unsigned char* y3 = ys + (size_t)(SEG[ei[q].w] + rk[q].w) * D + 4 * lane;
#pragma unroll
            for (int j = 0; j < 8; ++j) { yw[q][0][j] = *(const unsigned*)(y0 + 256 * j); yw[q][1][j] = *(const unsigned*)(y1 + 256 * j); yw[q][2][j] = *(const unsigned*)(y2 + 256 * j); yw[q][3][j] = *(const unsigned*)(y3 + 256 * j);
                xw[q][j] = *(const v2u*)(xinb + (size_t)tt * D + 256 * j + 4 * lane); } }
#pragma unroll
        for (int q = 0; q < 2; ++q) if (ok[q]) { const int t = t0 + q;
            f32x4 y[8]; float ss = 0.f;
#pragma unroll
            for (int j = 0; j < 8; ++j) { f32x4 acc = unpk4_fp8(yw[q][0][j]) * gg[q].x; acc += unpk4_fp8(yw[q][1][j]) * gg[q].y; acc += unpk4_fp8(yw[q][2][j]) * gg[q].z; acc += unpk4_fp8(yw[q][3][j]) * gg[q].w;
                y[j] = acc; ss += (acc.x * acc.x + acc.y * acc.y) + (acc.z * acc.z + acc.w * acc.w); }
            const float r1 = rsqrtf(wave_sum(ss) * (1.f / D) + EPS);
            const LAS float* mb = prm + (t / S - bA) * 3 * D;
            f32x4 v[8];
#pragma unroll
            for (int j = 0; j < 8; ++j) { const int c = 256 * j + 4 * lane;
                v[j] = (f32x4){bflo(xw[q][j].x), bfhi(xw[q][j].x), bflo(xw[q][j].y), bfhi(xw[q][j].y)} + *(const LAS f32x4*)(mb + c) * (y[j] * r1);
                if constexpr (LAST) *(f32x4*)(xo32 + (size_t)t * D + c) = v[j];
                else { v2u o; o.x = pk2(v[j].x, v[j].y); o.y = pk2(v[j].z, v[j].w); *(v2u*)(xob + (size_t)t * D + c) = o; } }
            if constexpr (!LAST) prenorm_store_lds(v, mb + D, mb + 2 * D, hb + (size_t)t * D, lane);
        }
    }
}
__device__ __forceinline__ void unpk8(const v4u q, float (&z)[8]) { z[0] = bflo(q.x); z[1] = bfhi(q.x); z[2] = bflo(q.y); z[3] = bfhi(q.y); z[4] = bflo(q.z); z[5] = bfhi(q.z); z[6] = bflo(q.w); z[7] = bfhi(q.w); }
template <int W>
__device__ __forceinline__ void pool_item(const bf16* __restrict__ pcg, unsigned char* __restrict__ mixcat, int t0, int ch0) {
    const int s0 = t0 & (S - 1);
    v4u raw[W - 1 + 16];
#pragma unroll
    for (int i = 0; i < W - 1 + 16; ++i) { const bool valid = (s0 != 0) || (i >= W - 1); const int row = valid ? t0 - (W - 1) + i : t0;
        const v4u q = *(const v4u*)(pcg + (size_t)row * 2048 + ch0); raw[i] = valid ? q : (v4u){0u, 0u, 0u, 0u}; }
    float sum[8];
#pragma unroll
    for (int k = 0; k < 8; ++k) sum[k] = 0.f;
#pragma unroll
    for (int i = 0; i < W - 1; ++i) { float z[8]; unpk8(raw[i], z);
#pragma unroll
        for (int k = 0; k < 8; ++k) sum[k] += z[k]; }
#pragma unroll
    for (int i = 0; i < 16; ++i) { float z[8]; unpk8(raw[W - 1 + i], z);
#pragma unroll
        for (int k = 0; k < 8; ++k) sum[k] += z[k];
        const int cnt = (s0 + i + 1 < W) ? s0 + i + 1 : W; const float inv = 1.f / (float)cnt;
        v2u o; o.x = pk4_fp8(sum[0] * inv - z[0], sum[1] * inv - z[1], sum[2] * inv - z[2], sum[3] * inv - z[3]);
        o.y = pk4_fp8(sum[4] * inv - z[4], sum[5] * inv - z[5], sum[6] * inv - z[6], sum[7] * inv - z[7]);
        *(v2u*)(mixcat + (size_t)(t0 + i) * D + 1024 + ch0) = o;
        float zo[8]; unpk8(raw[i], zo);
#pragma unroll
        for (int k = 0; k < 8; ++k) sum[k] -= zo[k]; }
}
__device__ __forceinline__ void conv_item(const bf16* __restrict__ pcg, const float* __restrict__ cw, unsigned char* __restrict__ mixcat, int t0, int ch0) {
    const int s0 = t0 & (S - 1);
    v4u cr[10], hr[10], br[8];
#pragma unroll
    for (int i = 0; i < 10; ++i) { const bool valid = (s0 != 0) || (i >= 2); const int row = valid ? t0 - 2 + i : t0;
        const v4u c4 = *(const v4u*)(pcg + (size_t)row * 2048 + 1024 + ch0), h4 = *(const v4u*)(pcg + (size_t)row * 2048 + 1536 + ch0);
        cr[i] = valid ? c4 : (v4u){0u, 0u, 0u, 0u}; hr[i] = valid ? h4 : (v4u){0u, 0u, 0u, 0u}; }
#pragma unroll
    for (int i = 0; i < 8; ++i) br[i] = *(const v4u*)(pcg + (size_t)(t0 + i) * 2048 + 512 + ch0);
    float w0[8], w1[8], w2[8];
#pragma unroll
    for (int k = 0; k < 8; ++k) { w0[k] = cw[ch0 + k]; w1[k] = cw[512 + ch0 + k]; w2[k] = cw[1024 + ch0 + k]; }
    float ua[8], ub[8];
    { float c[8], h[8]; unpk8(cr[0], c); unpk8(hr[0], h);
#pragma unroll
      for (int k = 0; k < 8; ++k) ua[k] = c[k] * h[k];
      unpk8(cr[1], c); unpk8(hr[1], h);
#pragma unroll
      for (int k = 0; k < 8; ++k) ub[k] = c[k] * h[k]; }
#pragma unroll
    for (int i = 0; i < 8; ++i) { float c[8], h[8], b[8], o[8]; unpk8(cr[i + 2], c); unpk8(hr[i + 2], h); unpk8(br[i], b);
#pragma unroll
        for (int k = 0; k < 8; ++k) { const float uc = c[k] * h[k]; o[k] = b[k] * (w0[k] * ua[k] + w1[k] * ub[k] + w2[k] * uc); ua[k] = ub[k]; ub[k] = uc; }
        v2u w; w.x = pk4_fp8(o[0], o[1], o[2], o[3]); w.y = pk4_fp8(o[4], o[5], o[6], o[7]);
        *(v2u*)(mixcat + (size_t)(t0 + i) * D + 1536 + ch0) = w; }
}
__device__ __forceinline__ void poolconv_phase(const Args& a, int l, int gw, int NGW) {
    int lane_l = threadIdx.x & 63; asm volatile("" : "+v"(lane_l));
    const int lane = lane_l;
    const bf16* pcg = (const bf16*)(a.ws + WS_PCG); unsigned char* mixcat = a.ws + WS_MIXCAT;
    const float* cw = a.in[I_CONVW] + (size_t)l * 3 * 512;
    for (int it = gw; it < T / 8 + (T / 64) * 4; it += NGW) {
        if (it < T / 8) conv_item(pcg, cw, mixcat, it * 8, lane * 8);
        else { const int r = it - T / 8, g = r & 3, t0 = (r >> 2) * 64 + (lane >> 4) * 16, ch0 = g * 128 + (lane & 15) * 8;
            if (g == 0) pool_item<2>(pcg, mixcat, t0, ch0); else if (g == 1) pool_item<4>(pcg, mixcat, t0, ch0); else if (g == 2) pool_item<8>(pcg, mixcat, t0, ch0); else pool_item<16>(pcg, mixcat, t0, ch0); }
    }
}

namespace att {
typedef float f32x16 __attribute__((ext_vector_type(16)));
typedef short s16x4 __attribute__((ext_vector_type(4)));
typedef const LAS char* lcp;
constexpr int NW = 8, QBLK = 32, KVBLK = 64, QB = 256, HD = 128;
constexpr int SHM_V = KVBLK * HD * 2, SHM_K = KVBLK * HD * 2;
constexpr int L_WS = 2 * SHM_V + 2 * SHM_K;
constexpr int L_KM = L_WS + NW * 64 * 4;
constexpr int L_LUT = L_KM + 4096;
constexpr int NQT = 216;
constexpr int LDS_ATT = L_LUT + NQT * 16;
static_assert(LDS_ATT <= RING_BYTES, "attention LDS");
constexpr float SCALE = 0.08838834764831845f, THR = 8.f;
constexpr int LDO = 2048;
#define KSWZ(row, colB) ((row) * 256 + ((colB) ^ (((row) & 7) << 4)))
#define SBAR() __builtin_amdgcn_sched_barrier(0)
__device__ __forceinline__ int v_st(int k, int c) { const int kk = (k & ~0xC) | ((k & 4) << 1) | ((k & 8) >> 1); return ((kk >> 3) * 4 + (c >> 5)) * 512 + ((kk & 7) * 32 + (c & 31)) * 2; }
__device__ __forceinline__ int v_rd_base(int lane) { return ((lane & 3) << 3) | (((lane >> 2) & 3) << 6) | (((lane >> 4) & 1) << 5) | (((lane >> 5) & 1) << 8); }
constexpr int v_rd_off(int d0, int ks, int half) { return d0 * 512 + ks * 4096 + half * 2048; }
__device__ __forceinline__ int crow(int r, int hi) { return (r & 3) + 8 * (r >> 2) + 4 * hi; }
__device__ __forceinline__ unsigned cvtpk(float lo, float hi) { unsigned r; asm volatile("v_cvt_pk_bf16_f32 %0, %1, %2" : "=v"(r) : "v"(lo), "v"(hi)); return r; }
__device__ __forceinline__ bf16x8 load8(const bf16* p) { return *reinterpret_cast<const bf16x8*>(p); }
__device__ __forceinline__ void partialSM(f32x16& p0, f32x16& p1, float& m_reg, float& mn, float& alpha) {
    float pmax = p0[0]; for (int r = 1; r < 16; ++r) pmax = fmaxf(pmax, p0[r]); for (int r = 0; r < 16; ++r) pmax = fmaxf(pmax, p1[r]);
    { auto rr = __builtin_amdgcn_permlane32_swap(__float_as_uint(pmax), __float_as_uint(pmax), false, false);
      pmax = fmaxf(__uint_as_float(rr[0]), __uint_as_float(rr[1])); }
    constexpr float C2 = 1.4426950408889634f * SCALE;
    if (__builtin_expect(__all((pmax - m_reg) * SCALE <= THR), 1)) { mn = m_reg; alpha = 1.f; }
    else { mn = fmaxf(m_reg, pmax); alpha = __builtin_amdgcn_exp2f((m_reg - mn) * C2); m_reg = mn; }
    const float mnL = -mn * C2;
    for (int r = 0; r < 16; ++r) p0[r] = fmaf(p0[r], C2, mnL); for (int r = 0; r < 16; ++r) p1[r] = fmaf(p1[r], C2, mnL);
    for (int r = 0; r < 16; ++r) p0[r] = __builtin_amdgcn_exp2f(p0[r]);
}
__device__ __forceinline__ void finishSM(f32x16& p0, f32x16& p1, float alpha, float& l_reg, bf16x8& pa0, bf16x8& pa1, bf16x8& pa2, bf16x8& pa3) {
    for (int r = 0; r < 16; ++r) p1[r] = __builtin_amdgcn_exp2f(p1[r]);
    float ps = 0; for (int r = 0; r < 16; ++r) ps += p0[r]; for (int r = 0; r < 16; ++r) ps += p1[r];
    { auto rr = __builtin_amdgcn_permlane32_swap(__float_as_uint(ps), __float_as_uint(ps), false, false);
      ps = __uint_as_float(rr[0]) + __uint_as_float(rr[1]); }
    l_reg = l_reg * alpha + ps;
#define PK4(P, B_, OUT) do { unsigned a0 = cvtpk(P[B_+0], P[B_+1]), a1 = cvtpk(P[B_+2], P[B_+3]);                          \
        unsigned b0 = cvtpk(P[B_+4], P[B_+5]), b1 = cvtpk(P[B_+6], P[B_+7]);                                             \
        auto r0 = __builtin_amdgcn_permlane32_swap(a0, b0, false, false); auto r1 = __builtin_amdgcn_permlane32_swap(a1, b1, false, false); \
        v4u w = {r0[0], r1[0], r0[1], r1[1]}; OUT = *reinterpret_cast<bf16x8*>(&w); } while (0)
    PK4(p0, 0, pa0); PK4(p0, 8, pa1); PK4(p1, 0, pa2); PK4(p1, 8, pa3);
#undef PK4
}
template <int KB>
__device__ __forceinline__ void qkt(f32x16& p0, f32x16& p1, lcp K_lds, int r32, int hi, const bf16x8* qr, float init) {
#pragma unroll
    for (int r = 0; r < 16; ++r) { p0[r] = init; p1[r] = init; }
    lcp kb[4];
#pragma unroll
    for (int dd = 0; dd < 4; ++dd) kb[dd] = K_lds + KB * SHM_K + KSWZ(r32, (dd * 16 + hi * 8) * 2);
#pragma unroll
    for (int d0 = 0; d0 < 8; ++d0) { lcp a = kb[d0 & 3] + (d0 >> 2) * 128;
        bf16x8 b0 = *reinterpret_cast<const LAS bf16x8*>(a);
        bf16x8 b1 = *reinterpret_cast<const LAS bf16x8*>(a + 32 * 256);
        p0 = __builtin_amdgcn_mfma_f32_32x32x16_bf16(b0, qr[d0], p0, 0, 0, 0);
        p1 = __builtin_amdgcn_mfma_f32_32x32x16_bf16(b1, qr[d0], p1, 0, 0, 0); }
}
template <int VB>
__device__ __forceinline__ void pv_tile(f32x16* o, int vb0, bf16x8 pa0, bf16x8 pa1, bf16x8 pa2, bf16x8 pa3) {
#define TRRD(dst, off) asm volatile("ds_read_b64_tr_b16 %0, %1 offset:%2" : "=&v"(dst) : "v"(vb0), "i"(off) : "memory")
#define PV_RD(L, Hh, ks) do { constexpr int b_ = VB * SHM_V + v_rd_off(0, ks, 0); TRRD(L[0], b_); TRRD(Hh[0], b_ + 2048); TRRD(L[1], b_ + 512); TRRD(Hh[1], b_ + 512 + 2048); \
        TRRD(L[2], b_ + 1024); TRRD(Hh[2], b_ + 1024 + 2048); TRRD(L[3], b_ + 1536); TRRD(Hh[3], b_ + 1536 + 2048); } while (0)
#define PV_MM(L, Hh, pa) do { _Pragma("unroll") for (int d0 = 0; d0 < 4; ++d0) \
        o[d0] = __builtin_amdgcn_mfma_f32_32x32x16_bf16(pa, (bf16x8){L[d0][0], L[d0][1], L[d0][2], L[d0][3], Hh[d0][0], Hh[d0][1], Hh[d0][2], Hh[d0][3]}, o[d0], 0, 0, 0); } while (0)
    s16x4 la[4], ha[4], lb[4], hb[4];
    PV_RD(la, ha, 0); PV_RD(lb, hb, 1);
    asm volatile("s_waitcnt lgkmcnt(8)" ::: "memory"); SBAR(); PV_MM(la, ha, pa0); SBAR();
    PV_RD(la, ha, 2);
    asm volatile("s_waitcnt lgkmcnt(8)" ::: "memory"); SBAR(); PV_MM(lb, hb, pa1); SBAR();
    PV_RD(lb, hb, 3);
    asm volatile("s_waitcnt lgkmcnt(8)" ::: "memory"); SBAR(); PV_MM(la, ha, pa2); SBAR();
    asm volatile("s_waitcnt lgkmcnt(0)" ::: "memory"); SBAR(); PV_MM(lb, hb, pa3);
#undef PV_RD
#undef PV_MM
#undef TRRD
}
__device__ __forceinline__ void bias_mask_tile(f32x16& p0, f32x16& p1, int dq, lcp qt, bool diag) {
#pragma unroll
    for (int j = 0; j < 4; ++j) {
        int i0 = dq - 8 * j, i1 = i0 - 32;
        i0 = i0 < 0 ? 0 : (i0 > NQT - 1 ? NQT - 1 : i0); i1 = i1 < 0 ? 0 : (i1 > NQT - 1 ? NQT - 1 : i1);
        const f32x4 q0 = *(const LAS f32x4*)(qt + i0 * 16), q1 = *(const LAS f32x4*)(qt + i1 * 16);
        p0[4 * j + 0] += q0[3]; p0[4 * j + 1] += q0[2]; p0[4 * j + 2] += q0[1]; p0[4 * j + 3] += q0[0];
        p1[4 * j + 0] += q1[3]; p1[4 * j + 1] += q1[2]; p1[4 * j + 2] += q1[1]; p1[4 * j + 3] += q1[0];
    }
    if (diag) {
        const float NEG = -__builtin_inff();
#pragma unroll
        for (int r = 0; r < 16; ++r) { const int c = (r & 3) + 8 * (r >> 2); if (dq - c < 0) p0[r] = NEG; if (dq - c - 32 < 0) p1[r] = NEG; }
    }
}
struct HeadRef { const bf16* Q; const bf16* K; const bf16* V; unsigned char* O; };
struct Seam { bf16x8 qr[8]; bf16x8 st_v0, st_v1, st_k0, st_k1; };
#define ROW(p, k0, rr) ((p) + (unsigned)(((k0) + (rr)) * HD + sc))
#define VMW() asm volatile("s_waitcnt vmcnt(0)" ::: "memory")
#define VMWN(n) asm volatile("s_waitcnt vmcnt(%0)" :: "i"(n) : "memory")
#define SLOAD_H(Kp, Vp, k0) do { S.st_v0 = load8(ROW(Vp, k0, sr)); S.st_v1 = load8(ROW(Vp, k0, 32 + sr));              \
                         S.st_k0 = load8(ROW(Kp, k0, sr)); S.st_k1 = load8(ROW(Kp, k0, 32 + sr)); } while (0)
#define SWRITE_HK(bf) do { *(LAS bf16x8*)(K_lds + (bf) * SHM_K + kws) = S.st_k0; *(LAS bf16x8*)(K_lds + (bf) * SHM_K + kws + 32 * 256) = S.st_k1; } while (0)
#define SWRITE_HV(bf) do { *(LAS bf16x8*)(V_lds + (bf) * SHM_V + vst0) = S.st_v0; *(LAS bf16x8*)(V_lds + (bf) * SHM_V + vst1) = S.st_v1; } while (0)
#define SWRITE_H(bf) do { SWRITE_HV(bf); SWRITE_HK(bf); } while (0)
__device__ __forceinline__ void stage_head(LAS char* lds, const float* __restrict__ kmsum, const float* __restrict__ relb, int h, int tid) {
    { LAS bf16* kmh = (LAS bf16*)(lds + L_KM); LAS bf16* kml = kmh + 1024;
      for (int i = tid; i < 1024; i += 512) { const float v = kmsum[i]; const unsigned hb_ = f2bf(v); kmh[i] = (bf16)hb_; kml[i] = (bf16)f2bf(v - bf2f(hb_)); } }
    if (tid < NQT) {
#pragma unroll
        for (int k = 0; k < 4; ++k) { int n = tid - 3 + k; n = n < 0 ? 0 : (n > 113 ? 113 : n); int bkt = n;
            if (n >= 16) { bkt = 16; bkt += (n >= 19); bkt += (n >= 21); bkt += (n >= 24); bkt += (n >= 27); bkt += (n >= 31); bkt += (n >= 35); bkt += (n >= 40); bkt += (n >= 46);
                bkt += (n >= 52); bkt += (n >= 59); bkt += (n >= 67); bkt += (n >= 77); bkt += (n >= 87); bkt += (n >= 99); bkt += (n >= 113); }
            ((LAS float*)(lds + L_LUT))[tid * 4 + k] = relb[bkt * 8 + h] * (1.0f / SCALE); } }
}
__device__ __forceinline__ void moba_block(const HeadRef& H, int qb, LAS char* lds, int tid) {
    const int wid = __builtin_amdgcn_readfirstlane(tid >> 6), lane = tid & 63, r32 = lane & 31, hi = lane >> 5;
    const int NT = 4 * (qb + 1);
    const int qlo = qb * QB + wid * QBLK, qm = qlo + r32 - 4 * hi;
    LAS char* V_lds = lds; LAS char* K_lds = lds + 2 * SHM_V;
    LAS float* ws = (LAS float*)(lds + L_WS) + wid * 64; LAS float* li_l = ws; LAS float* al_l = ws + 32;
    lcp lut = lds + L_LUT;
    unsigned kofs[2], vofs[2];
#pragma unroll
    for (int g2 = 0; g2 < 2; ++g2) { const int p = (wid + 8 * g2) * 64 + lane;
        { const int r = p >> 4, cc = (p & 15) ^ (r & 7); kofs[g2] = (unsigned)(r * HD + cc * 8); }
        { const int st = p >> 5, kk = (st >> 2) * 8 + ((p >> 2) & 7), k = (kk & ~0xC) | ((kk & 4) << 1) | ((kk & 8) >> 1), c = (st & 3) * 32 + (p & 3) * 8; vofs[g2] = (unsigned)(k * HD + c); } }
    const int vb0 = (int)(uintptr_t)V_lds + v_rd_base(lane);
    const bf16* Kh = H.K; const bf16* Vh = H.V;
    Seam S;
    { const bf16* curQ = H.Q + (unsigned)(qb * QB * HD);
#pragma unroll
      for (int d0 = 0; d0 < 8; ++d0) S.qr[d0] = load8(curQ + (unsigned)((wid * QBLK + r32) * HD + d0 * 16 + hi * 8)); }
#define DMA_TILE(t1, BUF1) do { _Pragma("unroll") for (int g2 = 0; g2 < 2; ++g2) {                                                                                      \
        __builtin_amdgcn_global_load_lds((const unsigned*)(Kh + (unsigned)(KBASE(t1) * HD) + kofs[g2]), (LAS unsigned*)(K_lds + (BUF1) * SHM_K + (wid + 8 * g2) * 1024), 16, 0, 0); \
        __builtin_amdgcn_global_load_lds((const unsigned*)(Vh + (unsigned)(KBASE(t1) * HD) + vofs[g2]), (LAS unsigned*)(V_lds + (BUF1) * SHM_V + (wid + 8 * g2) * 1024), 16, 0, 0); } } while (0)
#define KBASE(t) ((t) * KVBLK)
    DMA_TILE(0, 0);
    VMW();
    __syncthreads();
    unsigned selmask = 0u;
    if (qb > 0) {
        f32x16 gs;
#pragma unroll
        for (int r = 0; r < 16; ++r) gs[r] = 0.f;
        lcp kmh = lds + L_KM + (r32 & 7) * 256 + hi * 16;
#pragma unroll
        for (int d0 = 0; d0 < 8; ++d0) { const bf16x8 ah = *reinterpret_cast<const LAS bf16x8*>(kmh + d0 * 32), al = *reinterpret_cast<const LAS bf16x8*>(kmh + 2048 + d0 * 32);
            gs = __builtin_amdgcn_mfma_f32_32x32x16_bf16(ah, S.qr[d0], gs, 0, 0, 0); gs = __builtin_amdgcn_mfma_f32_32x32x16_bf16(al, S.qr[d0], gs, 0, 0, 0); }
        float g[8];
#pragma unroll
        for (int r = 0; r < 4; ++r) { const float mine = gs[r], oth = __shfl_xor(mine, 32); g[r] = hi ? oth : mine; g[4 + r] = hi ? mine : oth; }
#pragma unroll
        for (int pass = 0; pass < 3; ++pass) { int best = -1; float bv = -__builtin_inff();
#pragma unroll
            for (int n = 0; n < 7; ++n) { const bool take = (n < qb) && !((selmask >> n) & 1u) && g[n] > bv; bv = take ? g[n] : bv; best = take ? n : best; }
            if (best >= 0) selmask |= 1u << best; }
    }
    const float cfar = __builtin_bit_cast(float, __builtin_amdgcn_readfirstlane(__builtin_bit_cast(int, *(const LAS float*)(lut + (113 + 3) * 16))));
    float m_reg = -1e30f, l_reg = 0; f32x16 o[4] = {};
#define FAR(t) (qlo - (KBASE(t) + KVBLK - 1) >= 113)
#define INITV(t) (((((t) >> 2) == qb) || ((selmask >> ((t) >> 2)) & 1u)) ? (FAR(t) ? cfar : 0.f) : -__builtin_inff())
#define MASKT(P0_, P1_, t) do { if (!FAR(t)) bias_mask_tile(P0_, P1_, qm - KBASE(t), lut, KBASE(t) + KVBLK - 1 > qlo); } while (0)
#define RESC(a) do { if (__any((a) < 1.f)) { if (hi == 0) al_l[r32] = (a); asm volatile("s_waitcnt lgkmcnt(0)" ::: "memory");              \
                     for (int d_ = 0; d_ < 4; ++d_) for (int r = 0; r < 16; ++r) o[d_][r] *= al_l[crow(r, hi)]; } } while (0)
    f32x16 p0, p1; float mn, al; bf16x8 pa0, pa1, pa2, pa3;
#define TILE_STEP(t, BUF) do {                                                                                               \
        if ((t) + 1 < NT) DMA_TILE((t) + 1, 1 - BUF);     \
        if (KBASE(t) <= qlo + QBLK - 1) {     \
        SBAR(); qkt<BUF>(p0, p1, K_lds, r32, hi, S.qr, INITV(t));                                                            \
        MASKT(p0, p1, (t)); partialSM(p0, p1, m_reg, mn, al); RESC(al); finishSM(p0, p1, al, l_reg, pa0, pa1, pa2, pa3); SBAR(); \
        pv_tile<BUF>(o, vb0, pa0, pa1, pa2, pa3); }                                                                           \
        VMW();                                                                                                                \
        __syncthreads(); } while (0)
    if (wid < 4) __builtin_amdgcn_s_setprio(2); else __builtin_amdgcn_s_setprio(0);
    for (int t = 0; t < NT; t += 2) { TILE_STEP(t, 0); TILE_STEP(t + 1, 1); }
    __builtin_amdgcn_s_setprio(0);
    if (hi == 0) li_l[r32] = l_reg; asm volatile("s_waitcnt lgkmcnt(0)" ::: "memory");
    float rli[16];
#pragma unroll
    for (int r = 0; r < 16; ++r) rli[r] = __builtin_amdgcn_rcpf(li_l[crow(r, hi)]);
    unsigned char* Ow = H.O + (unsigned)((qb * QB + wid * QBLK) * LDO);
    LAS unsigned char* ot = (LAS unsigned char*)K_lds + wid * 4096;
#pragma unroll
    for (int r = 0; r < 16; ++r) { const int orow = crow(r, hi);
#pragma unroll
        for (int d0 = 0; d0 < 4; ++d0) ot[orow * 128 + d0 * 32 + r32] = (unsigned char)(__builtin_amdgcn_cvt_pk_fp8_f32(clamp448(o[d0][r] * rli[r]), 0.f, 0, false) & 0xffu); }
    asm volatile("s_waitcnt lgkmcnt(0)" ::: "memory");
#pragma unroll
    for (int it = 0; it < 4; ++it) { const int row = it * 8 + (lane >> 3), ch = lane & 7;
        *(v4u*)(Ow + (unsigned)(row * LDO + ch * 16)) = *(const LAS v4u*)(ot + row * 128 + ch * 16); }
    __syncthreads();
#undef RESC
#undef KBASE
#undef FAR
#undef INITV
#undef MASKT
#undef TILE_STEP
#undef DMA_TILE
}
#undef ROW
#undef VMW
#undef VMWN
#undef SLOAD_H
#undef SWRITE_HK
#undef SWRITE_HV
#undef SWRITE_H
#undef KSWZ
#undef SBAR
}
__device__ __forceinline__ void attn_phase(const Args& a, LAS unsigned char* lds_u, int l, int G, int vcu) {
    int tid_l = threadIdx.x; asm volatile("" : "+v"(tid_l));
    const int tid = tid_l;
    LAS char* lds = (LAS char*)lds_u;
    const bf16* Qb = (const bf16*)(a.ws + WS_Q); const bf16* Kb = (const bf16*)(a.ws + WS_K); const bf16* Vb = (const bf16*)(a.ws + WS_V); unsigned char* mixcat = a.ws + WS_MIXCAT;
    const float* kmsum = (const float*)(a.ws + WS_KMEAN) + (size_t)l * 8 * 8 * 8 * 128;
    for (int L = vcu; L < 256; L += G) {
        const int bh = L >> 2, y = L & 3, b = bh >> 3, h = bh & 7;
        const size_t hbase = (size_t)bh * S * 128;
        att::HeadRef H; H.Q = Qb + hbase; H.K = Kb + hbase; H.V = Vb + hbase; H.O = mixcat + (size_t)b * S * D + h * 128;
        __syncthreads();
        att::stage_head(lds, kmsum + (size_t)bh * 8 * 128, a.in[I_RELB], h, tid);
#pragma unroll 1
        for (int pass = 0; pass < 2; ++pass) att::moba_block(H, pass ? 7 - y : y, lds, tid);
    }
}

constexpr int NPHASE = 3 + 7 * NL;
__global__ void __launch_bounds__(NWAVES * 64, 2) mk_fwd(Args args) {
    extern __shared__ __attribute__((aligned(16))) unsigned char lds_raw[];
    LAS unsigned char* lds = (LAS unsigned char*)lds_raw;
    const int tid = threadIdx.x, lane = tid & 63, wave = __builtin_amdgcn_readfirstlane(tid >> 6);
    const int G = gridDim.x, bx = blockIdx.x, vcu = (G % 8 == 0) ? (bx % 8) * (G / 8) + bx / 8 : bx;
    const int gw = vcu * NWAVES + wave, NGW = G * NWAVES;
    volatile LAS unsigned* MISC = (volatile LAS unsigned*)(lds + LX_MISC);
    if (tid < 16) MISC[tid] = 0u;
    __syncthreads();
    unsigned* ctl = (unsigned*)(args.ws + WS_CTL);
    XcdBarrier bar = xcd_barrier_post(ctl + CW_BAR + args.li * XCD_BAR_WORDS, MISC);
    const int lo = args.ph_lo, hi = args.ph_hi;
#define IN(k) (lo <= (k) && (k) < hi)
#define SEAM(k) do { if (IN(k) && IN((k) + 1)) xcd_barrier(bar); } while (0)
    if (IN(0)) p0a(args, lds, gw, NGW, wave, lane, tid);
    SEAM(0);
    if (IN(1)) { p0b(args, gw, NGW, lane); p0c(args, lds, gw, NGW, lane, tid); }
    SEAM(1);
    for (int l = 0; l < NL; ++l) {
        const int pb = 3 + 7 * l;
        if (IN(pb + 0)) {
            pg8::DenseOrder So; So.init((const bf16*)(args.ws + WS_HB), (const bf16*)(args.ws + WS_WIN + (size_t)l * DIN * D), T, DIN, D / 2, G, bx);
            pg8::EpiInProj E{(bf16*)(args.ws + WS_Q), (WS_K - WS_Q) / 2, (bf16*)(args.ws + WS_PCG), (float*)(args.ws + WS_KMEAN) + (size_t)l * 8 * 8 * 8 * 128, 1.f / WSCALE};
            pg8::gemm_phase<pg8::EpiInProj, pg8::DenseOrder, true, true>(lds, D / 2, So, E);
        }
        SEAM(pb + 0);
        if (IN(pb + 1)) {
            const bool early = ((bx >> 3) & 1) == 0;
            if (early) { weight_transposes<3>(args, lds, gw, NGW, wave, lane, l, l == 0 ? 1 : -1); __syncthreads(); }
            attn_phase(args, lds, l, G, vcu); poolconv_phase(args, l, gw, NGW);
            if (!early) { __syncthreads(); weight_transposes<3>(args, lds, gw, NGW, wave, lane, l, l == 0 ? 1 : -1); }
        }
        SEAM(pb + 1);
        if (IN(pb + 2)) {
            pg8::DenseOrder So; So.init((const bf16*)(args.ws + WS_MIXCAT), (const bf16*)(args.ws + WS_WOUT + (size_t)l * D * D), T, D, D / 2, G, bx);
            pg8::EpiPlain E{(bf16*)(args.ws + WS_MIX), D, nullptr, 1.f / WSCALE};
            pg8::gemm_phase<pg8::EpiPlain, pg8::DenseOrder, true, true>(lds, D / 2, So, E);
        }
        SEAM(pb + 2);
        if (IN(pb + 3)) row1_phase(args, lds, l, G, bx);
        SEAM(pb + 3);
        if (IN(pb + 4)) {
            pg8::GroupedGather So; grouped_prepare(lds, (const int*)(ctl + CW_COUNTS + l * 32), (const int*)(args.ws + WS_ROWTOK), true, G, bx, So);
            So.A = (const char*)(args.ws + WS_HB8); So.Bt = (const char*)(args.ws + WS_WGU + (size_t)l * NE * 2048 * D); So.K = D / 2;
            pg8::EpiGU E{args.ws + WS_ACT, args.in[I_BG] + (size_t)l * NE * DE, args.in[I_BU] + (size_t)l * NE * DE, 1.f / WSCALE, (LAS float*)(lds + LX_BIAS)};
            pg8::gemm_phase<pg8::EpiGU, pg8::GroupedGather, true, true>(lds, D / 2, So, E);
        }
        SEAM(pb + 4);
        if (IN(pb + 5)) {
            pg8::GroupedDense So; grouped_prepare(lds, (const int*)(ctl + CW_COUNTS + l * 32), (const int*)(args.ws + WS_ROWTOK), false, G, bx, So);
            So.A = (const char*)(args.ws + WS_ACT); So.Bt = (const char*)(args.ws + WS_WDN + (size_t)l * NE * 2048 * DE); So.K = DE / 2;
            pg8::EpiPlain8 E{args.ws + WS_YS, args.in[I_BD] + (size_t)l * NE * D, 1.f / WSCALE, (LAS float*)(lds + LX_BIAS)};
            pg8::gemm_phase<pg8::EpiPlain8, pg8::GroupedDense, true, true>(lds, DE / 2, So, E);
        }
        SEAM(pb + 5);
        if (IN(pb + 6)) { if (l + 1 < NL) row2_phase<false>(args, lds, l, gw, NGW); else row2_phase<true>(args, lds, l, gw, NGW); }
        SEAM(pb + 6);
    }
#undef IN
#undef SEAM
}

static void launch_mk(const Args& base, int lo, int hi, int li, int grid, hipStream_t stream) {
    Args a = base; a.ph_lo = lo; a.ph_hi = hi; a.li = li; a.pad = 0;
    hipLaunchKernelGGL(mk_fwd, dim3(grid), dim3(NWAVES * 64), LDS_BYTES, stream, a);
}
extern "C" void kernel_launch(void* const* d_in, const int* in_sizes, int n_in, void* d_out, int out_size, void* d_ws, size_t ws_size, hipStream_t stream) {
    static int grid = 0;
    if (grid == 0) {
        if (n_in != 22 || out_size != T * D || ws_size < WS_END) { fprintf(stderr, "kernel_launch: unexpected shapes / workspace (%d inputs, out %d, ws %zu)\n", n_in, out_size, ws_size); grid = -1; return; }
        int dev = 0, cus = 0, per_cu = 0;
        (void)hipGetDevice(&dev); (void)hipDeviceGetAttribute(&cus, hipDeviceAttributeMultiprocessorCount, dev);
        (void)hipFuncSetAttribute((const void*)mk_fwd, hipFuncAttributeMaxDynamicSharedMemorySize, LDS_BYTES);
        (void)hipOccupancyMaxActiveBlocksPerMultiprocessor(&per_cu, (const void*)mk_fwd, NWAVES * 64, LDS_BYTES);
        if (per_cu < 1) fprintf(stderr, "kernel_launch: occupancy query says %d blocks per CU\n", per_cu);
        (void)hipGetLastError();
        grid = cus >= 64 ? (cus / 64) * 64 : 64;
    }
    if (grid < 0) return;
    unsigned char* ws = (unsigned char*)d_ws;
    (void)hipMemsetAsync(ws + WS_CTL, 0, CTL_ZERO_BYTES, stream);
    Args a{};
    for (int i = 0; i < 22; ++i) a.in[i] = (const float*)d_in[i];
    a.out = (float*)d_out; a.ws = ws;
    launch_mk(a, 0, NPHASE, 0, grid, stream);
}
```
